# Optimizing an MI355X kernel written in HIP

```python
import math
import jax, jax.numpy as jnp
from jax import lax
import numpy as np

D_MODEL = 2048
BATCH = 1
SEQ = 8192
DEPTH = 4

HEAD_DIM = 128
MLA_HEADS = 8
MLA_Q_RANK = 512
MLA_KV_RANK = 512
MLA_NOPE_DIM = 128
MLA_ROPE_DIM = 64
MLA_V_DIM = 128
MLA_QK_DIM = MLA_NOPE_DIM + MLA_ROPE_DIM
DIL_HEADS = 8
DIL_PATTERNS = ((128, 1), (512, 4), (2048, 16))
ROPE_THETA = 500000.0
PARTIAL_ROPE_DIM = HEAD_DIM // 4
D_FF = 5632
Q_BLOCK = 128
RMS_EPS = 1e-6
NEG = -1e30
MLA_WIDTH = MLA_HEADS * MLA_V_DIM
DIL_WIDTH = DIL_HEADS * HEAD_DIM
D_MIX = MLA_WIDTH + DIL_WIDTH
IN_SIZES = (MLA_Q_RANK, MLA_KV_RANK, MLA_ROPE_DIM, DIL_WIDTH, DIL_WIDTH, DIL_WIDTH)
IN_COLS = sum(IN_SIZES)
IN_SPLITS = tuple(int(v) for v in np.cumsum(IN_SIZES)[:-1])

kernel_name = "hymba_mla_dilated_macaron_sandwich"


def rms_norm(x, g):
    xf = x.astype(jnp.float32)
    y = xf * lax.rsqrt(jnp.mean(xf * xf, axis=-1, keepdims=True) + RMS_EPS)
    return (y * g.astype(jnp.float32)).astype(x.dtype)


def swiglu(h, w_gate, w_up, w_down):
    return (jax.nn.silu(h @ w_gate) * (h @ w_up)) @ w_down


def rope_tables(positions, dim):
    inv = ROPE_THETA ** (-jnp.arange(0, dim, 2, dtype=jnp.float32) / dim)
    ang = positions.astype(jnp.float32)[..., None] * inv
    return jnp.cos(ang), jnp.sin(ang)


def apply_rope(x, cos, sin):
    xf = x.astype(jnp.float32)
    x1, x2 = jnp.split(xf, 2, axis=-1)
    out = jnp.concatenate([x1 * cos - x2 * sin, x2 * cos + x1 * sin], axis=-1)
    return out.astype(x.dtype)


def mla_attention(q_nope, q_rope, k_nope, k_rope, v):
    B, S, H, _ = q_nope.shape
    nb = S // Q_BLOCK
    scale = 1.0 / math.sqrt(MLA_QK_DIM)
    key_idx = jnp.arange(S)

    def to_blocks(t):
        return jnp.moveaxis(t.reshape(B, nb, Q_BLOCK, *t.shape[2:]), 1, 0)

    def one_block(args):
        qn_b, qr_b, i = args
        s = (jnp.einsum('bqhd,bkhd->bhqk', qn_b, k_nope).astype(jnp.float32)
             + jnp.einsum('bqhr,bkr->bhqk', qr_b, k_rope).astype(jnp.float32)) * scale
        q_idx = i * Q_BLOCK + jnp.arange(Q_BLOCK)
        mask = key_idx[None, :] <= q_idx[:, None]
        s = jnp.where(mask, s, NEG)
        p = jax.nn.softmax(s, axis=-1).astype(v.dtype)
        return jnp.einsum('bhqk,bkhd->bqhd', p, v)

    o = lax.map(one_block, (to_blocks(q_nope), to_blocks(q_rope), jnp.arange(nb)))
    return jnp.moveaxis(o, 0, 1).reshape(B, S, H, -1)


def dilated_window_attention(q, k, v, window, dilation):
    B, S, H, Dh = q.shape
    span = window // dilation
    blk = span
    seg = blk * dilation
    s_pad = -(-S // seg) * seg
    L = s_pad // dilation
    nb = L // blk
    scale = 1.0 / math.sqrt(Dh)

    def to_sub(t):
        t = jnp.pad(t, ((0, 0), (0, s_pad - S), (0, 0), (0, 0)))
        t = t.reshape(B, L, dilation, H, Dh).transpose(0, 2, 1, 3, 4)
        return t.reshape(B, dilation, nb, blk, H, Dh)

    def with_prev(t):
        prev = jnp.pad(t[:, :, :-1], ((0, 0), (0, 0), (1, 0), (0, 0), (0, 0), (0, 0)))
        return jnp.concatenate([prev, t], axis=3)

    qb = to_sub(q)
    kc = with_prev(to_sub(k))
    vc = with_prev(to_sub(v))
    s = jnp.einsum('brnqhd,brnkhd->brnhqk', qb, kc).astype(jnp.float32) * scale
    qi = jnp.arange(blk)[:, None]
    kj = jnp.arange(2 * blk)[None, :]
    dist = blk + qi - kj
    band = (dist >= 0) & (dist <= span)
    valid_prev = (jnp.arange(nb)[:, None, None] > 0) | (kj >= blk)[None]
    mask = band[None] & valid_prev
    s = jnp.where(mask[None, None, :, None], s, NEG)
    lse = jax.nn.logsumexp(s, axis=-1)
    p = jnp.exp(s - lse[..., None]).astype(v.dtype)
    o = jnp.einsum('brnhqk,brnkhd->brnqhd', p, vc)

    def from_sub(t):
        rest = t.shape[4:]
        t = t.reshape(B, dilation, L, *rest)
        t = jnp.moveaxis(t, 1, 2).reshape(B, s_pad, *rest)
        return t[:, :S]

    return from_sub(o), from_sub(jnp.moveaxis(lse, -1, -2))


def dilated_mixture(q, k, v):
    outs, lses = [], []
    for window, dilation in DIL_PATTERNS:
        o_p, lse_p = dilated_window_attention(q, k, v, window, dilation)
        outs.append(o_p)
        lses.append(lse_p)
    w = jax.nn.softmax(jnp.stack(lses, axis=0), axis=0)
    return jnp.einsum('pbsh,pbshd->bshd', w.astype(q.dtype), jnp.stack(outs, axis=0))


def setup_inputs(seed: int = 0) -> dict:
    key = jax.random.key(seed)
    ks = jax.random.split(key, 24)

    def w(k, shape, fan_in):
        return jax.random.normal(k, shape, jnp.float32) * (fan_in ** -0.5)

    def gain(k, n):
        return 1.0 + 0.1 * jax.random.normal(k, (DEPTH, n), jnp.float32)

    x = jax.random.normal(ks[0], (BATCH, SEQ, D_MODEL), jnp.float32)
    offset = jax.random.randint(ks[1], (BATCH, 1), 0, 1024, dtype=jnp.int32)
    positions = (offset + jnp.arange(SEQ, dtype=jnp.int32)[None, :]).astype(jnp.int32)
    return {
        "x": x,
        "positions": positions,
        "ffn1_pre_g": gain(ks[2], D_MODEL),
        "ffn1_post_g": gain(ks[3], D_MODEL),
        "ffn1_w_gate": w(ks[4], (DEPTH, D_MODEL, D_FF), D_MODEL),
        "ffn1_w_up": w(ks[5], (DEPTH, D_MODEL, D_FF), D_MODEL),
        "ffn1_w_down": w(ks[6], (DEPTH, D_FF, D_MODEL), D_FF),
        "mix_pre_g": gain(ks[7], D_MODEL),
        "mix_post_g": gain(ks[8], D_MODEL),
        "w_in": w(ks[9], (DEPTH, D_MODEL, IN_COLS), D_MODEL),
        "mla_q_norm_g": gain(ks[10], MLA_Q_RANK),
        "mla_w_uq": w(ks[11], (DEPTH, MLA_Q_RANK, MLA_HEADS * MLA_QK_DIM), MLA_Q_RANK),
        "mla_kv_norm_g": gain(ks[12], MLA_KV_RANK),
        "mla_w_ukv": w(ks[13], (DEPTH, MLA_KV_RANK, MLA_HEADS * (MLA_NOPE_DIM + MLA_V_DIM)), MLA_KV_RANK),
        "w_o": w(ks[14], (DEPTH, D_MIX, D_MODEL), D_MIX),
        "ffn2_pre_g": gain(ks[15], D_MODEL),
        "ffn2_post_g": gain(ks[16], D_MODEL),
        "ffn2_w_gate": w(ks[17], (DEPTH, D_MODEL, D_FF), D_MODEL),
        "ffn2_w_up": w(ks[18], (DEPTH, D_MODEL, D_FF), D_MODEL),
        "ffn2_w_down": w(ks[19], (DEPTH, D_FF, D_MODEL), D_FF),
    }


def reference(x, positions, ffn1_pre_g, ffn1_post_g, ffn1_w_gate, ffn1_w_up, ffn1_w_down,
              mix_pre_g, mix_post_g, w_in, mla_q_norm_g, mla_w_uq, mla_kv_norm_g, mla_w_ukv,
              w_o, ffn2_pre_g, ffn2_post_g, ffn2_w_gate, ffn2_w_up, ffn2_w_down):
    B, S, _ = x.shape
    cos_a, sin_a = rope_tables(positions, MLA_ROPE_DIM)
    cos_p, sin_p = rope_tables(positions, PARTIAL_ROPE_DIM)

    def partial_rope(t):
        return jnp.concatenate([apply_rope(t[..., :PARTIAL_ROPE_DIM], cos_p[:, :, None], sin_p[:, :, None]),
                                t[..., PARTIAL_ROPE_DIM:]], axis=-1)

    for l in range(DEPTH):
        h = rms_norm(x, ffn1_pre_g[l])
        x = x + 0.5 * rms_norm(swiglu(h, ffn1_w_gate[l], ffn1_w_up[l], ffn1_w_down[l]), ffn1_post_g[l])

        h = rms_norm(x, mix_pre_g[l])
        proj = h @ w_in[l]
        c_q, c_kv, k_rope, q_d, k_d, v_d = jnp.split(proj, IN_SPLITS, axis=-1)

        q_a = (rms_norm(c_q, mla_q_norm_g[l]) @ mla_w_uq[l]).reshape(B, S, MLA_HEADS, MLA_QK_DIM)
        q_nope, q_rope = q_a[..., :MLA_NOPE_DIM], q_a[..., MLA_NOPE_DIM:]
        q_rope = apply_rope(q_rope, cos_a[:, :, None], sin_a[:, :, None])
        k_rope = apply_rope(k_rope, cos_a, sin_a)
        kv = (rms_norm(c_kv, mla_kv_norm_g[l]) @ mla_w_ukv[l]).reshape(B, S, MLA_HEADS, MLA_NOPE_DIM + MLA_V_DIM)
        k_nope, v_a = kv[..., :MLA_NOPE_DIM], kv[..., MLA_NOPE_DIM:]
        o_a = mla_attention(q_nope, q_rope, k_nope, k_rope, v_a)

        q_b = partial_rope(q_d.reshape(B, S, DIL_HEADS, HEAD_DIM))
        k_b = partial_rope(k_d.reshape(B, S, DIL_HEADS, HEAD_DIM))
        v_b = v_d.reshape(B, S, DIL_HEADS, HEAD_DIM)
        o_b = dilated_mixture(q_b, k_b, v_b)

        o = jnp.concatenate([o_a.reshape(B, S, MLA_WIDTH), o_b.reshape(B, S, DIL_WIDTH)], axis=-1) @ w_o[l]
        x = x + rms_norm(o, mix_post_g[l])

        h = rms_norm(x, ffn2_pre_g[l])
        x = x + 0.5 * rms_norm(swiglu(h, ffn2_w_gate[l], ffn2_w_up[l], ffn2_w_down[l]), ffn2_post_g[l])
    return x
```

```cpp
#include <hip/hip_runtime.h>
#include <cstdio>
#include <cstdint>
constexpr int S = 8192, DM = 2048, DFF = 5632, DEPTH = 4, NIN_PHYS = 4352  , NIN = 4160;
constexpr int NWAVES = 8;
#ifndef MK_SINGLE_LAUNCH
#define MK_SINGLE_LAUNCH 0
#endif
constexpr int N_PHASES = 1 + DEPTH * 11;
constexpr size_t MiB = 1u << 20;
constexpr size_t WS_CTL = 0, CTL_ZERO_BYTES = 1 * MiB;
constexpr size_t WS_TA = 1 * MiB, WS_TP = 3 * MiB, WS_SSQQ = 4 * MiB, WS_SSQKV = 4 * MiB + 256 * 1024, WS_LSE2 = 4 * MiB + 512 * 1024, WS_LSE3 = 4 * MiB + 768 * 1024, WS_KR = 5 * MiB;
constexpr size_t WS_H = 8 * MiB, WS_ACT = 40 * MiB, WS_Y = 128 * MiB, WS_CQ = 192 * MiB, WS_CKV = 200 * MiB, WS_DQ = 208 * MiB, WS_DK = 224 * MiB, WS_DV = 240 * MiB;
constexpr size_t WS_QA = 256 * MiB, WS_KN = 280 * MiB, WS_VA = 296 * MiB, WS_OCAT = 312 * MiB, WS_O2 = 344 * MiB, WS_O3 = 360 * MiB, WS_W = 384 * MiB;
constexpr size_t W_GU = (size_t)2 * DFF * DM * 2, W_D = (size_t)DM * DFF * 2, W_IN = (size_t)NIN_PHYS * DM * 2, W_UQ = (size_t)1536 * 512 * 2, W_UKV = (size_t)2048 * 512 * 2, W_O = (size_t)DM * DM * 2;
constexpr size_t WO_GU1 = 0, WO_D1 = WO_GU1 + W_GU, WO_IN = WO_D1 + W_D, WO_UQ = WO_IN + W_IN, WO_UKV = WO_UQ + W_UQ, WO_O = WO_UKV + W_UKV, WO_GU2 = WO_O + W_O, WO_D2 = WO_GU2 + W_GU, W_LAYER = WO_D2 + W_D;
constexpr size_t WS_END = WS_W + DEPTH * W_LAYER;
static_assert(W_LAYER % 256 == 0 && (size_t)S * DFF * 2 <= WS_Y - WS_ACT && (size_t)S * DM * 4 <= WS_CQ - WS_Y, "d_ws map");
constexpr int CW_BAR = 4096;
constexpr int RING_OFF = 0, RING_BYTES = 131072, LDSCTL_OFF = RING_BYTES, MISC_OFF = LDSCTL_OFF + 320, LDS_BYTES = 147456;

namespace pg8 {
#define PG8_LAS __attribute__((address_space(3)))
typedef unsigned short bf16_t;
typedef short bf16x8 __attribute__((ext_vector_type(8)));
typedef float f32x4 __attribute__((ext_vector_type(4)));
typedef unsigned u32x4 __attribute__((ext_vector_type(4)));
constexpr int BM = 256, BK = 64, HALF = 128, HTB = HALF * BK * 2  , STAGE_BYTES = 8 * HTB, NXCD = 8, WGM = 8;

__host__ __device__ __forceinline__ int lds_byte(int r, int c) { const int st = (r >> 4) * 2 + (c >> 5), rr = r & 15, cc = c & 31, ob = rr * 64 + cc * 2; return st * 1024 + (ob ^ (((ob >> 9) & 1) << 5)); }
__host__ __device__ __forceinline__ void stage_rc(int b, int& R, int& C) { const int st = b / 1024, sb = b % 1024, swz = sb ^ (((sb >> 9) & 1) << 5); R = (st >> 1) * 16 + swz / 64; C = (st & 1) * 32 + (swz % 64) / 2; }
__host__ __device__ __forceinline__ int perm32(int rho) { const int n = rho >> 4, i = rho & 15; return 8 * (i >> 2) + 4 * n + (i & 3); }

struct Unit { int pm, pn; };
struct Gemm { const bf16_t* A; const bf16_t* Bt; int M, N, K; };

struct StaticOrder {
    int nM, nN, nwg, G, c;
    __host__ __device__ void init(int M, int N, int G_, int c_) { nM = M / BM; nN = N / BM; nwg = nM * nN; G = G_; c = c_; }
    __host__ __device__ bool next(int i, Unit& u) const {
        const long L = (long)i * G + c; if (L >= nwg) return false;
        int wgid = (int)L; { const int q = nwg / NXCD, r = nwg % NXCD, xcd = wgid % NXCD, off = wgid / NXCD; wgid = (xcd < r ? xcd * (q + 1) : r * (q + 1) + (xcd - r) * q) + off; }
        const int nig = WGM * nN, gid = wgid / nig, fm = gid * WGM, gsz = (nM - fm) < WGM ? (nM - fm) : WGM;
        u.pm = fm + ((wgid % nig) % gsz); u.pn = (wgid % nig) / gsz; return true;
    }
    __device__ __forceinline__ void a_ready(const Unit&) const {}
    __device__ __forceinline__ void done(const Unit&) const {}
};

__device__ __forceinline__ unsigned cvt_pk_bf16(float lo, float hi) { unsigned r; asm volatile("v_cvt_pk_bf16_f32 %0, %1, %2" : "=v"(r) : "v"(lo), "v"(hi)); return r; }
typedef float f32x2 __attribute__((ext_vector_type(2)));
__device__ __forceinline__ u32x4 pack8f(f32x4 a, f32x4 b) { u32x4 w; w.x = cvt_pk_bf16(a[0], a[1]); w.y = cvt_pk_bf16(a[2], a[3]); w.z = cvt_pk_bf16(b[0], b[1]); w.w = cvt_pk_bf16(b[2], b[3]); return w; }
__device__ __forceinline__ float silu_mul(float g, float u) { const float e = __builtin_amdgcn_exp2f(-1.4426950408889634f * g); return g * u * __builtin_amdgcn_rcpf(1.0f + e); }
constexpr float RMS_EPS_F = 1e-6f;

struct EpiF32 {
    static constexpr bool PERM = false, AFTER_DRAIN = false;
    float* C; int ldc;
    __device__ __forceinline__ void operator()(const f32x4 (&acc)[2][2][4][2], const Unit& u, int wr, int wc, int fr, int fq) const {
        const int row0 = u.pm * BM + wr * 64 + fr, col0 = u.pn * BM + wc * 32 + 4 * fq;
#pragma unroll
        for (int ai = 0; ai < 2; ++ai)
#pragma unroll
            for (int m = 0; m < 4; ++m) { float* rowp = C + (size_t)(row0 + ai * HALF + m * 16) * ldc + col0;
#pragma unroll
                for (int bj = 0; bj < 2; ++bj)
#pragma unroll
                    for (int n = 0; n < 2; ++n) *(f32x4*)(rowp + bj * HALF + n * 16) = acc[ai][bj][m][n]; }
    }
};
struct EpiSwiGLU {
    static constexpr bool PERM = true, AFTER_DRAIN = false;
    bf16_t* O; int ldc;
    __device__ __forceinline__ void operator()(const f32x4 (&acc)[2][2][4][2], const Unit& u, int wr, int wc, int fr, int fq) const {
        const int row0 = u.pm * BM + wr * 64 + fr, col0 = u.pn * HALF + wc * 32 + 8 * fq;
#pragma unroll
        for (int ai = 0; ai < 2; ++ai)
#pragma unroll
            for (int m = 0; m < 4; ++m) { bf16_t* rowp = O + (size_t)(row0 + ai * HALF + m * 16) * ldc + col0; f32x4 r0, r1;
#pragma unroll
                for (int j = 0; j < 4; ++j) { r0[j] = silu_mul(acc[ai][0][m][0][j], acc[ai][1][m][0][j]); r1[j] = silu_mul(acc[ai][0][m][1][j], acc[ai][1][m][1][j]); }
                *(u32x4*)rowp = pack8f(r0, r1); }
    }
};
struct EpiWin {
    static constexpr bool PERM = true, AFTER_DRAIN = false;
    unsigned char* ws;
    __device__ __forceinline__ void operator()(const f32x4 (&acc)[2][2][4][2], const Unit& u, int wr, int wc, int fr, int fq) const {
        bf16_t* const CQ = (bf16_t*)(ws + WS_CQ); bf16_t* const CKV = (bf16_t*)(ws + WS_CKV); bf16_t* const DQ = (bf16_t*)(ws + WS_DQ); bf16_t* const DK = (bf16_t*)(ws + WS_DK); bf16_t* const DV = (bf16_t*)(ws + WS_DV); bf16_t* const KR = (bf16_t*)(ws + WS_KR);
        float* const SSQ_Q = (float*)(ws + WS_SSQQ); float* const SSQ_KV = (float*)(ws + WS_SSQKV); const float* const TA = (const float*)(ws + WS_TA); const float* const TP = (const float*)(ws + WS_TP);
        const int row0 = u.pm * BM + wr * 64 + fr, pn = u.pn;
        if (pn < 4) {
            bf16_t* dst = pn < 2 ? CQ : CKV; float* ssq = pn < 2 ? SSQ_Q : SSQ_KV; const int colt = (pn & 1) * 256 + wc * 32 + 8 * fq;
#pragma unroll
            for (int ai = 0; ai < 2; ++ai)
#pragma unroll
                for (int m = 0; m < 4; ++m) { const int row = row0 + ai * HALF + m * 16; float s = 0.f;
#pragma unroll
                    for (int bj = 0; bj < 2; ++bj) { const f32x4 v0 = acc[ai][bj][m][0], v1 = acc[ai][bj][m][1];
                        s += (v0[0] * v0[0] + v0[1] * v0[1]) + (v0[2] * v0[2] + v0[3] * v0[3]) + (v1[0] * v1[0] + v1[1] * v1[1]) + (v1[2] * v1[2] + v1[3] * v1[3]);
                        *(u32x4*)(dst + (size_t)row * 512 + colt + bj * HALF) = pack8f(v0, v1); }
                    s += __shfl_xor(s, 16); s += __shfl_xor(s, 32);
                    if (fq == 0) ssq[(size_t)row * 8 + (pn & 1) * 4 + wc] = s; }
        } else if (pn < 12) {
            bf16_t* dst = pn < 8 ? DQ : DK; const int t = (pn - 4) & 3;
            if (wc == 0) {
                const int head = 2 * t + (fq >> 1), f0 = 8 * (fq & 1);
#pragma unroll
                for (int ai = 0; ai < 2; ++ai)
#pragma unroll
                    for (int m = 0; m < 4; ++m) { const int row = row0 + ai * HALF + m * 16; const float* tp = TP + (size_t)row * 32 + f0;
                        const f32x4 c0 = *(const f32x4*)tp, c1 = *(const f32x4*)(tp + 4), s0 = *(const f32x4*)(tp + 16), s1 = *(const f32x4*)(tp + 20);
                        const f32x4 x1a = acc[ai][0][m][0], x1b = acc[ai][0][m][1], x2a = acc[ai][1][m][0], x2b = acc[ai][1][m][1];
                        bf16_t* o = dst + (size_t)row * 1024 + head * 128 + f0;
                        *(u32x4*)o = pack8f(x1a * c0 - x2a * s0, x1b * c1 - x2b * s1);
                        *(u32x4*)(o + 16) = pack8f(x2a * c0 + x1a * s0, x2b * c1 + x1b * s1); }
            } else {
                const int q = wc * 32 + 8 * fq;
#pragma unroll
                for (int ai = 0; ai < 2; ++ai)
#pragma unroll
                    for (int m = 0; m < 4; ++m) { const int row = row0 + ai * HALF + m * 16;
#pragma unroll
                        for (int bj = 0; bj < 2; ++bj) *(u32x4*)(dst + (size_t)row * 1024 + (2 * t + bj) * 128 + q) = pack8f(acc[ai][bj][m][0], acc[ai][bj][m][1]); }
            }
        } else if (pn < 16) {
            const int colt = (pn - 12) * 256 + wc * 32 + 8 * fq;
#pragma unroll
            for (int ai = 0; ai < 2; ++ai)
#pragma unroll
                for (int m = 0; m < 4; ++m) { const int row = row0 + ai * HALF + m * 16;
#pragma unroll
                    for (int bj = 0; bj < 2; ++bj) *(u32x4*)(DV + (size_t)row * 1024 + colt + bj * HALF) = pack8f(acc[ai][bj][m][0], acc[ai][bj][m][1]); }
        } else {
            if (wc == 0) {
                const int f0 = 8 * fq;
#pragma unroll
                for (int ai = 0; ai < 2; ++ai)
#pragma unroll
                    for (int m = 0; m < 4; ++m) { const int row = row0 + ai * HALF + m * 16; const float* ta = TA + (size_t)row * 64 + f0;
                        const f32x4 c0 = *(const f32x4*)ta, c1 = *(const f32x4*)(ta + 4), s0 = *(const f32x4*)(ta + 32), s1 = *(const f32x4*)(ta + 36);
                        const f32x4 x1a = acc[ai][0][m][0], x1b = acc[ai][0][m][1], x2a = acc[ai][1][m][0], x2b = acc[ai][1][m][1];
                        bf16_t* o = KR + (size_t)row * 64 + f0;
                        *(u32x4*)o = pack8f(x1a * c0 - x2a * s0, x1b * c1 - x2b * s1);
                        *(u32x4*)(o + 32) = pack8f(x2a * c0 + x1a * s0, x2b * c1 + x1b * s1); }
            }
        }
    }
};
__device__ __forceinline__ float row_rs512(const float* ssq, int row) { const f32x4 a = *(const f32x4*)(ssq + (size_t)row * 8), b = *(const f32x4*)(ssq + (size_t)row * 8 + 4);
    const float s = ((a[0] + a[1]) + (a[2] + a[3])) + ((b[0] + b[1]) + (b[2] + b[3])); return 1.0f / sqrtf(s * (1.0f / 512.0f) + RMS_EPS_F); }
struct EpiUq {
    static constexpr bool PERM = true, AFTER_DRAIN = false;
    unsigned char* ws;
    __device__ __forceinline__ void operator()(const f32x4 (&acc)[2][2][4][2], const Unit& u, int wr, int wc, int fr, int fq) const {
        bf16_t* const QA = (bf16_t*)(ws + WS_QA); const float* const SSQ = (const float*)(ws + WS_SSQQ); const float* const TA = (const float*)(ws + WS_TA);
        const int row0 = u.pm * BM + wr * 64 + fr, pn = u.pn;
#pragma unroll
        for (int ai = 0; ai < 2; ++ai)
#pragma unroll
            for (int m = 0; m < 4; ++m) { const int row = row0 + ai * HALF + m * 16; const float rs = row_rs512(SSQ, row);
                if (pn < 4) {
#pragma unroll
                    for (int bj = 0; bj < 2; ++bj) *(u32x4*)(QA + (size_t)row * 1536 + (2 * pn + bj) * 192 + wc * 32 + 8 * fq) = pack8f(acc[ai][bj][m][0] * rs, acc[ai][bj][m][1] * rs);
                } else {
                    const int head = 4 * (pn - 4) + wc, f0 = 8 * fq; const float* ta = TA + (size_t)row * 64 + f0;
                    const f32x4 c0 = *(const f32x4*)ta, c1 = *(const f32x4*)(ta + 4), s0 = *(const f32x4*)(ta + 32), s1 = *(const f32x4*)(ta + 36);
                    const f32x4 x1a = acc[ai][0][m][0] * rs, x1b = acc[ai][0][m][1] * rs, x2a = acc[ai][1][m][0] * rs, x2b = acc[ai][1][m][1] * rs;
                    bf16_t* o = QA + (size_t)row * 1536 + head * 192 + 128 + f0;
                    *(u32x4*)o = pack8f(x1a * c0 - x2a * s0, x1b * c1 - x2b * s1);
                    *(u32x4*)(o + 32) = pack8f(x2a * c0 + x1a * s0, x2b * c1 + x1b * s1);
                } }
    }
};
struct EpiUkv {
    static constexpr bool PERM = true, AFTER_DRAIN = false;
    unsigned char* ws;
    __device__ __forceinline__ void operator()(const f32x4 (&acc)[2][2][4][2], const Unit& u, int wr, int wc, int fr, int fq) const {
        bf16_t* const KN = (bf16_t*)(ws + WS_KN); bf16_t* const VA = (bf16_t*)(ws + WS_VA); const float* const SSQ = (const float*)(ws + WS_SSQKV);
        const int row0 = u.pm * BM + wr * 64 + fr, col = u.pn * 128 + wc * 32 + 8 * fq;
#pragma unroll
        for (int ai = 0; ai < 2; ++ai)
#pragma unroll
            for (int m = 0; m < 4; ++m) { const int row = row0 + ai * HALF + m * 16; const float rs = row_rs512(SSQ, row);
                *(u32x4*)(KN + (size_t)row * 1024 + col) = pack8f(acc[ai][0][m][0] * rs, acc[ai][0][m][1] * rs);
                *(u32x4*)(VA + (size_t)row * 1024 + col) = pack8f(acc[ai][1][m][0] * rs, acc[ai][1][m][1] * rs); }
    }
};

template <class Epi, class Sched, bool ALIGN_EPI = false, bool SP2 = false>
__device__ __forceinline__ void gemm_phase(PG8_LAS unsigned char* lds, const Gemm g, const Sched& S, const Epi& E) {
    int tid_ = threadIdx.x; asm volatile("" : "+v"(tid_));
    const int tid = tid_, wid = __builtin_amdgcn_readfirstlane(tid >> 6), lane = tid & 63, wr = wid >> 2, wc = wid & 3, fr = lane & 15, fq = lane >> 4;
    const int K = g.K, nt = K / BK;
    unsigned voffA[2], voffB[2];
#pragma unroll
    for (int i = 0; i < 2; ++i) { int R, C; stage_rc(tid * 16 + i * 8192, R, C); const int Rb = Epi::PERM ? ((R & ~31) + perm32(R & 31)) : R;
        voffA[i] = (unsigned)(R * K + C) * 2u; voffB[i] = (unsigned)(Rb * K + C) * 2u; }
    const size_t kstep = (size_t)(BK * 2);
    const size_t hstep = (size_t)HALF * K * 2;
    const size_t tstep = 2 * hstep;
    const unsigned ldsw = (unsigned)wid * 1024u;
    const int aoff = lds_byte(wr * 64 + fr, fq * 8), boff = lds_byte(wc * 32 + fr, fq * 8);
#define PG8_SA(b, h) (((b) * 2 + (h)) * HTB)
#define PG8_SB(b, h) ((4 + (b) * 2 + (h)) * HTB)
#define PG8_STAGE(bufoff, gbase, voff) do { _Pragma("unroll") for (int _i = 0; _i < 2; ++_i) \
        __builtin_amdgcn_global_load_lds((const unsigned*)((const char*)(gbase) + (voff)[_i]), (PG8_LAS unsigned*)(lds + (bufoff) + ldsw + _i * 8192), 16, 0, 0); } while (0)
#define PG8_LDA(dst, b, h) do { _Pragma("unroll") for (int m = 0; m < 4; ++m) _Pragma("unroll") for (int k = 0; k < 2; ++k) dst[m][k] = *(const PG8_LAS bf16x8*)(lds + PG8_SA(b, h) + aoff + m * 2048 + k * 1024); } while (0)
#define PG8_LDB(dst, b, h) do { _Pragma("unroll") for (int n = 0; n < 2; ++n) _Pragma("unroll") for (int k = 0; k < 2; ++k) dst[n][k] = *(const PG8_LAS bf16x8*)(lds + PG8_SB(b, h) + boff + n * 2048 + k * 1024); } while (0)
#define PG8_MMA(ai, bj, At, Bt) do { __builtin_amdgcn_s_setprio(1); _Pragma("unroll") for (int m = 0; m < 4; ++m) _Pragma("unroll") for (int n = 0; n < 2; ++n) _Pragma("unroll") for (int k = 0; k < 2; ++k) \
        acc[ai][bj][m][n] = __builtin_amdgcn_mfma_f32_16x16x32_bf16(Bt[n][k], At[m][k], acc[ai][bj][m][n], 0, 0, 0); __builtin_amdgcn_s_setprio(0); } while (0)
#define PG8_WAIT_V(n) asm volatile("s_waitcnt vmcnt(" #n ")" ::: "memory")
#define PG8_WAIT_L(n) asm volatile("s_waitcnt lgkmcnt(" #n ")" ::: "memory")
#define PG8_BAR __builtin_amdgcn_s_barrier()
#define PG8_SCHED __builtin_amdgcn_sched_barrier(0)
    Unit cur, nxt; int ui = 0;
    if (!S.next(0, cur)) return;
    f32x4 acc[2][2][4][2];
#pragma unroll
    for (int a = 0; a < 2; ++a)
#pragma unroll
        for (int b = 0; b < 2; ++b)
#pragma unroll
            for (int m = 0; m < 4; ++m)
#pragma unroll
                for (int n = 0; n < 2; ++n) acc[a][b][m][n] = (f32x4){0.f, 0.f, 0.f, 0.f};
    bf16x8 At[4][2], B0[2][2], B1[2][2];
    const char* cA = (const char*)g.A + (size_t)cur.pm * tstep; const char* cB = (const char*)g.Bt + (size_t)cur.pn * tstep;
    S.a_ready(cur);
    if constexpr (SP2) {
        PG8_STAGE(PG8_SB(0, 0), cB, voffB); PG8_STAGE(PG8_SB(0, 1), cB + hstep, voffB); PG8_STAGE(PG8_SA(0, 0), cA, voffA); PG8_STAGE(PG8_SA(0, 1), cA + hstep, voffA);
        if (wr == 1) PG8_BAR;
        PG8_WAIT_V(2); PG8_BAR;
        PG8_STAGE(PG8_SB(1, 0), cB + kstep, voffB); PG8_STAGE(PG8_SA(1, 0), cA + kstep, voffA); PG8_STAGE(PG8_SB(1, 1), cB + hstep + kstep, voffB);
        PG8_WAIT_V(6); PG8_BAR;
    } else {
        PG8_STAGE(PG8_SB(0, 0), cB, voffB); PG8_STAGE(PG8_SA(0, 0), cA, voffA); PG8_STAGE(PG8_SB(0, 1), cB + hstep, voffB); PG8_STAGE(PG8_SA(0, 1), cA + hstep, voffA);
        if (wr == 1) PG8_BAR;
        PG8_WAIT_V(4); PG8_BAR;
        PG8_STAGE(PG8_SB(1, 0), cB + kstep, voffB); PG8_STAGE(PG8_SA(1, 0), cA + kstep, voffA); PG8_STAGE(PG8_SB(1, 1), cB + hstep + kstep, voffB);
        PG8_WAIT_V(6); PG8_BAR;
    }
    for (;;) {
        const bool has_next = S.next(ui + 1, nxt);
        const char* nA = has_next ? (const char*)g.A + (size_t)nxt.pm * tstep : cA; const char* nB = has_next ? (const char*)g.Bt + (size_t)nxt.pn * tstep : cB;
        for (int t = 0; t < nt; t += 2) {
            const bool last = (t == nt - 2);
            const char* a1 = cA + (size_t)(t + 1) * kstep;
            const char* a2 = last ? nA : cA + (size_t)(t + 2) * kstep; const char* b2 = last ? nB : cB + (size_t)(t + 2) * kstep;
            const char* a3 = a2 + kstep; const char* b3 = b2 + kstep;
            if (last && has_next) S.a_ready(nxt);
            if constexpr (SP2) {
            PG8_LDB(B0, 0, 0); PG8_LDB(B1, 0, 1); PG8_SCHED; PG8_LDA(At, 0, 0); PG8_STAGE(PG8_SA(1, 1), a1 + hstep, voffA);
            PG8_WAIT_V(8); PG8_WAIT_L(0); PG8_BAR; PG8_MMA(0, 0, At, B0); PG8_MMA(0, 1, At, B1); PG8_BAR; PG8_SCHED;
            PG8_LDA(At, 0, 1); PG8_STAGE(PG8_SB(0, 0), b2, voffB); PG8_STAGE(PG8_SB(0, 1), b2 + hstep, voffB); PG8_STAGE(PG8_SA(0, 0), a2, voffA);
            PG8_WAIT_V(8); PG8_WAIT_L(0); PG8_BAR; PG8_MMA(1, 0, At, B0); PG8_MMA(1, 1, At, B1); PG8_BAR; PG8_SCHED;
            PG8_LDB(B0, 1, 0); PG8_LDB(B1, 1, 1); PG8_SCHED; PG8_LDA(At, 1, 0); PG8_STAGE(PG8_SA(0, 1), a2 + hstep, voffA);
            PG8_WAIT_V(8); PG8_WAIT_L(0); PG8_BAR; PG8_MMA(0, 0, At, B0); PG8_MMA(0, 1, At, B1); PG8_BAR; PG8_SCHED;
            PG8_LDA(At, 1, 1); PG8_STAGE(PG8_SB(1, 0), b3, voffB); PG8_STAGE(PG8_SB(1, 1), b3 + hstep, voffB); PG8_STAGE(PG8_SA(1, 0), a3, voffA);
            PG8_WAIT_V(8); PG8_WAIT_L(0); PG8_BAR; PG8_MMA(1, 0, At, B0); PG8_MMA(1, 1, At, B1); PG8_BAR; PG8_SCHED;
            } else {
            PG8_LDB(B0, 0, 0); PG8_SCHED; PG8_LDA(At, 0, 0); PG8_STAGE(PG8_SA(1, 1), a1 + hstep, voffA);
            PG8_WAIT_L(8); PG8_BAR; PG8_WAIT_L(0); PG8_MMA(0, 0, At, B0); PG8_BAR; PG8_SCHED;
            PG8_LDB(B1, 0, 1); PG8_STAGE(PG8_SB(0, 0), b2, voffB);
            PG8_BAR; PG8_WAIT_L(0); PG8_MMA(0, 1, At, B1); PG8_BAR;
            PG8_LDA(At, 0, 1); PG8_STAGE(PG8_SA(0, 0), a2, voffA);
            PG8_BAR; PG8_WAIT_L(0); PG8_MMA(1, 0, At, B0); PG8_BAR; PG8_SCHED;
            PG8_STAGE(PG8_SB(0, 1), b2 + hstep, voffB);
            PG8_WAIT_V(6); PG8_BAR; PG8_MMA(1, 1, At, B1); PG8_BAR;
            PG8_LDB(B0, 1, 0); PG8_SCHED; PG8_LDA(At, 1, 0); PG8_STAGE(PG8_SA(0, 1), a2 + hstep, voffA);
            PG8_WAIT_L(8); PG8_BAR; PG8_WAIT_L(0); PG8_MMA(0, 0, At, B0); PG8_BAR; PG8_SCHED;
            PG8_LDB(B1, 1, 1); PG8_STAGE(PG8_SB(1, 0), b3, voffB);
            PG8_BAR; PG8_WAIT_L(0); PG8_MMA(0, 1, At, B1); PG8_BAR;
            PG8_LDA(At, 1, 1); PG8_STAGE(PG8_SA(1, 0), a3, voffA);
            PG8_BAR; PG8_WAIT_L(0); PG8_MMA(1, 0, At, B0); PG8_BAR; PG8_SCHED;
            PG8_STAGE(PG8_SB(1, 1), b3 + hstep, voffB);
            PG8_WAIT_V(6); PG8_BAR; PG8_MMA(1, 1, At, B1); PG8_BAR;
            }
        }
        if constexpr (ALIGN_EPI) { if (wr == 0) PG8_BAR; }
        if constexpr (!Epi::AFTER_DRAIN) { E(acc, cur, wr, wc, fr, fq); S.done(cur); }
        if (!has_next) break;
#pragma unroll
        for (int a = 0; a < 2; ++a)
#pragma unroll
            for (int b = 0; b < 2; ++b)
#pragma unroll
                for (int m = 0; m < 4; ++m)
#pragma unroll
                    for (int n = 0; n < 2; ++n) acc[a][b][m][n] = (f32x4){0.f, 0.f, 0.f, 0.f};
        cur = nxt; cA = nA; cB = nB; ++ui;
        if constexpr (ALIGN_EPI) { if (wr == 1) PG8_BAR; }
    }
    PG8_WAIT_V(0);
    if constexpr (!ALIGN_EPI) { if (wr == 0) PG8_BAR; }
    PG8_BAR;
    if constexpr (Epi::AFTER_DRAIN) { E.fused(acc, cur, wr, wc, fr, fq, lds, wid, lane); S.done(cur); }
#undef PG8_SA
#undef PG8_SB
#undef PG8_STAGE
#undef PG8_LDA
#undef PG8_LDB
#undef PG8_MMA
#undef PG8_WAIT_V
#undef PG8_WAIT_L
#undef PG8_BAR
#undef PG8_SCHED
}
}
#define GAS __attribute__((address_space(1)))
#define LAS __attribute__((address_space(3)))
typedef unsigned short bf16;
typedef unsigned v4u __attribute__((ext_vector_type(4)));
typedef float f32x4 __attribute__((ext_vector_type(4)));
typedef short bf16x8 __attribute__((ext_vector_type(8)));
typedef GAS unsigned gu32;
typedef GAS unsigned long long gu64;
#define RLX_AGENT __ATOMIC_RELAXED, __HIP_MEMORY_SCOPE_AGENT
#define LDS_WAIT() asm volatile("s_waitcnt lgkmcnt(0)" ::: "memory")
#define VM_WAIT() asm volatile("s_waitcnt vmcnt(0)" ::: "memory")
__device__ __forceinline__ unsigned long long rt() { return __builtin_amdgcn_s_memrealtime(); }
__device__ __forceinline__ unsigned f2bf(float f) { unsigned u = __builtin_bit_cast(unsigned, f); return (u + 0x7fffu + ((u >> 16) & 1u)) >> 16; }
__device__ __forceinline__ unsigned pk2(float lo, float hi) { return f2bf(lo) | (f2bf(hi) << 16); }
#define XB_TMO      128
#define XB_XCNT(j)  (256  + 64 * (j))
#define XB_XSUB(j)  (1280 + 64 * (j))
#define XB_XGEN(j)  (2304 + 64 * (j))
#define XB_TOP      3328
#define XB_TOPGEN   3392
#define XCD_BAR_WORDS 3456
#define XB_SPIN_CAP (1u << 18)

__device__ __forceinline__ unsigned xb_ld(unsigned* p)              { return __hip_atomic_load(p, __ATOMIC_RELAXED, __HIP_MEMORY_SCOPE_AGENT); }
__device__ __forceinline__ unsigned xb_add(unsigned* p, unsigned v) { return __hip_atomic_fetch_add(p, v, __ATOMIC_RELAXED, __HIP_MEMORY_SCOPE_AGENT); }
__device__ __forceinline__ unsigned xb_xcc_id() { return (unsigned)__builtin_amdgcn_s_getreg((3 << 11) | 20) & 0xFu; }
#define XB_SPIN(cond, bar) do { unsigned _sp = 0; while (cond) { __builtin_amdgcn_s_sleep(1); \
    if ((++_sp & 255u) == 0u) { if (xb_ld(&(bar)[XB_TMO])) break; if (_sp > XB_SPIN_CAP) { atomicAdd(&(bar)[XB_TMO], 1u); break; } } } } while (0)

struct XcdBarrier {
    unsigned* bar; unsigned x;
    volatile LAS unsigned* st;
};

__device__ __forceinline__ XcdBarrier xcd_barrier_post(unsigned* bar, volatile LAS unsigned* st) {
    XcdBarrier b; b.bar = bar; b.x = xb_xcc_id(); b.st = st;
    if (threadIdx.x == 0) (void)xb_add(&bar[XB_XCNT(b.x)], 1u);
    return b;
}
__device__ __forceinline__ void xcd_barrier_complete(unsigned* bar, unsigned x, unsigned& nloc, unsigned& nx) {
    const unsigned G = gridDim.x * gridDim.y * gridDim.z;
    unsigned sum, cnt, mine, sp = 0u;
    for (;;) {
        sum = 0u; cnt = 0u; mine = 0u;
#pragma unroll
        for (unsigned j = 0; j < 16; ++j) { const unsigned c = xb_ld(&bar[XB_XCNT(j)]); sum += c; cnt += (c > 0u) ? 1u : 0u; mine = (j == x) ? c : mine; }
        if (sum == G) break;
        __builtin_amdgcn_s_sleep(1);
        if ((++sp & 255u) == 0u) { if (xb_ld(&bar[XB_TMO])) break; if (sp > XB_SPIN_CAP) { atomicAdd(&bar[XB_TMO], 1u); break; } }
    }
    nloc = mine > 0u ? mine : 1u; nx = cnt > 0u ? cnt : 1u;
}

__device__ __forceinline__ void xcd_barrier(const XcdBarrier& b) {
    asm volatile("s_waitcnt vmcnt(0)" ::: "memory");
    __syncthreads();
    if (threadIdx.x == 0) {
        unsigned* bar = b.bar;
        __builtin_amdgcn_s_waitcnt(0);
        unsigned nloc = b.st[0], nx = b.st[1];
        if (nloc == 0u) { xcd_barrier_complete(bar, b.x, nloc, nx); b.st[0] = nloc; b.st[1] = nx; }
        const unsigned old = xb_add(&bar[XB_XSUB(b.x)], 1u);
        const unsigned gen = old / nloc;
        if (old + 1u == (gen + 1u) * nloc) {
            __builtin_amdgcn_fence(__ATOMIC_RELEASE, "agent");
            asm volatile("s_waitcnt vmcnt(0)" ::: "memory");
            const unsigned og = xb_add(&bar[XB_TOP], 1u);
            const unsigned tg = og / nx;
            if (og + 1u == (tg + 1u) * nx) xb_add(&bar[XB_TOPGEN], 1u);
            else XB_SPIN(xb_ld(&bar[XB_TOPGEN]) == tg, bar);
            __builtin_amdgcn_fence(__ATOMIC_ACQUIRE, "agent");
            xb_add(&bar[XB_XGEN(b.x)], 1u);
            asm volatile("s_waitcnt vmcnt(0)" ::: "memory");
        } else {
            XB_SPIN(xb_ld(&bar[XB_XGEN(b.x)]) == gen, bar);
            __builtin_amdgcn_fence(__ATOMIC_ACQUIRE, "agent");
            asm volatile("s_waitcnt vmcnt(0)" ::: "memory");
        }
    }
    __syncthreads();
}
namespace att {
typedef short bf16x8 __attribute__((ext_vector_type(8)));
typedef short s16x4 __attribute__((ext_vector_type(4)));
typedef float f32x16 __attribute__((ext_vector_type(16)));
typedef float f32x4 __attribute__((ext_vector_type(4)));
typedef unsigned u32x4 __attribute__((ext_vector_type(4)));
typedef unsigned short bf16;
#define ALAS __attribute__((address_space(3)))
typedef ALAS unsigned char* lptr;
constexpr int G_BYTES = 40960, KT_OFF = 0, VT_OFF = 24576;
constexpr int SCR_OFF = 81920;
constexpr int OM_OFF = 0, ML_OFF = 65536;
constexpr int ATT_LDS_BYTES = SCR_OFF + 8 * 512;
#define ASBAR() __builtin_amdgcn_sched_barrier(0)

__device__ __forceinline__ int v_st(int k, int c) { const int kk = (k & ~0xC) | ((k & 4) << 1) | ((k & 8) >> 1); return ((kk >> 3) * 4 + (c >> 5)) * 512 + ((kk & 7) * 32 + (c & 31)) * 2; }
__device__ __forceinline__ int v_rd_base(int lane) { return ((lane & 3) << 3) | (((lane >> 2) & 3) << 6) | (((lane >> 4) & 1) << 5) | (((lane >> 5) & 1) << 8); }
constexpr int v_rd_off(int d0, int ks, int half) { return d0 * 512 + ks * 4096 + half * 2048; }
__device__ __forceinline__ int crow(int r, int hi) { return (r & 3) + 8 * (r >> 2) + 4 * hi; }
__device__ __forceinline__ unsigned cvtpk(float lo, float hi) { unsigned r; asm volatile("v_cvt_pk_bf16_f32 %0, %1, %2" : "=v"(r) : "v"(lo), "v"(hi)); return r; }

__device__ __forceinline__ void mask_tile(f32x16& p0, f32x16& p1, int dq, unsigned W) {
    const float NEG = -__builtin_inff();
#pragma unroll
    for (int r = 0; r < 16; ++r) {
        const int c = (r & 3) + 8 * (r >> 2);
        if ((unsigned)(dq - c) >= W) p0[r] = NEG;
        if ((unsigned)(dq - c - 32) >= W) p1[r] = NEG;
    }
}
__device__ __forceinline__ void partialSM(f32x16& p0, f32x16& p1, float& m_reg, float& mn, float& alpha, const float C2, const float THRR) {
    float pmax = p0[0];
#pragma unroll
    for (int r = 1; r < 16; ++r) pmax = fmaxf(pmax, p0[r]);
#pragma unroll
    for (int r = 0; r < 16; ++r) pmax = fmaxf(pmax, p1[r]);
    { auto rr = __builtin_amdgcn_permlane32_swap(__float_as_uint(pmax), __float_as_uint(pmax), false, false);
      pmax = fmaxf(__uint_as_float(rr[0]), __uint_as_float(rr[1])); }
    if (__builtin_expect(__all((pmax - m_reg) <= THRR), 1)) { mn = m_reg; alpha = 1.f; }
    else { mn = fmaxf(m_reg, pmax); alpha = __builtin_amdgcn_exp2f((m_reg - mn) * C2); m_reg = mn; }
    const float mnL = -mn * C2;
#pragma unroll
    for (int r = 0; r < 16; ++r) p0[r] = fmaf(p0[r], C2, mnL);
#pragma unroll
    for (int r = 0; r < 16; ++r) p1[r] = fmaf(p1[r], C2, mnL);
#pragma unroll
    for (int r = 0; r < 16; ++r) p0[r] = __builtin_amdgcn_exp2f(p0[r]);
}
__device__ __forceinline__ void finishSM(f32x16& p0, f32x16& p1, float alpha, float& l_reg, bf16x8& pa0, bf16x8& pa1, bf16x8& pa2, bf16x8& pa3) {
#pragma unroll
    for (int r = 0; r < 16; ++r) p1[r] = __builtin_amdgcn_exp2f(p1[r]);
    float ps = 0;
#pragma unroll
    for (int r = 0; r < 16; ++r) ps += p0[r];
#pragma unroll
    for (int r = 0; r < 16; ++r) ps += p1[r];
    { auto rr = __builtin_amdgcn_permlane32_swap(__float_as_uint(ps), __float_as_uint(ps), false, false);
      ps = __uint_as_float(rr[0]) + __uint_as_float(rr[1]); }
    l_reg = l_reg * alpha + ps;
#define ATT_PK4(P, B_, OUT) do { unsigned a0 = cvtpk(P[B_+0], P[B_+1]), a1 = cvtpk(P[B_+2], P[B_+3]);                          \
        unsigned b0 = cvtpk(P[B_+4], P[B_+5]), b1 = cvtpk(P[B_+6], P[B_+7]);                                             \
        auto r0 = __builtin_amdgcn_permlane32_swap(a0, b0, false, false); auto r1 = __builtin_amdgcn_permlane32_swap(a1, b1, false, false); \
        u32x4 w = {r0[0], r1[0], r0[1], r1[1]}; OUT = __builtin_bit_cast(bf16x8, w); } while (0)
    ATT_PK4(p0, 0, pa0); ATT_PK4(p0, 8, pa1); ATT_PK4(p1, 0, pa2); ATT_PK4(p1, 8, pa3);
#undef ATT_PK4
}
template <int KSTR> __device__ __forceinline__ int kswz(int row) { return KSTR == 384 ? ((row >> 1) & 7) : (row & 7); }
template <int ND0, int KSTR>
__device__ __forceinline__ void qkt(f32x16& p0, f32x16& p1, lptr Kt, int r32, int hi, const bf16x8* qr) {
#pragma unroll
    for (int r = 0; r < 16; ++r) { p0[r] = 0.f; p1[r] = 0.f; }
    const int sw = kswz<KSTR>(r32) << 4;
    lptr kb[4];
#pragma unroll
    for (int dd = 0; dd < 4; ++dd) kb[dd] = Kt + r32 * KSTR + ((dd * 32 + hi * 16) ^ sw);
#pragma unroll
    for (int d0 = 0; d0 < ND0; ++d0) { lptr a = kb[d0 & 3] + (d0 >> 2) * 128;
        const bf16x8 b0 = *(const ALAS bf16x8*)a;
        const bf16x8 b1 = *(const ALAS bf16x8*)(a + 32 * KSTR);
        p0 = __builtin_amdgcn_mfma_f32_32x32x16_bf16(b0, qr[d0], p0, 0, 0, 0);
        p1 = __builtin_amdgcn_mfma_f32_32x32x16_bf16(b1, qr[d0], p1, 0, 0, 0); }
}
__device__ __forceinline__ void pv_tile(f32x16* o, unsigned vb0, bf16x8 pa0, bf16x8 pa1, bf16x8 pa2, bf16x8 pa3) {
#define ATT_TRRD(dst, off) asm volatile("ds_read_b64_tr_b16 %0, %1 offset:%2" : "=&v"(dst) : "v"(vb0), "i"(off) : "memory")
#define ATT_PV_D0(d0) do { s16x4 l0, l1, l2, l3, h0, h1, h2, h3; constexpr int b_ = v_rd_off(d0, 0, 0); \
        ATT_TRRD(l0, b_); ATT_TRRD(h0, b_ + 2048); ATT_TRRD(l1, b_ + 4096); ATT_TRRD(h1, b_ + 6144); ATT_TRRD(l2, b_ + 8192); ATT_TRRD(h2, b_ + 10240); ATT_TRRD(l3, b_ + 12288); ATT_TRRD(h3, b_ + 14336); \
        asm volatile("s_waitcnt lgkmcnt(0)" ::: "memory"); ASBAR(); \
        o[d0] = __builtin_amdgcn_mfma_f32_32x32x16_bf16(pa0, (bf16x8){l0[0], l0[1], l0[2], l0[3], h0[0], h0[1], h0[2], h0[3]}, o[d0], 0, 0, 0);   \
        o[d0] = __builtin_amdgcn_mfma_f32_32x32x16_bf16(pa1, (bf16x8){l1[0], l1[1], l1[2], l1[3], h1[0], h1[1], h1[2], h1[3]}, o[d0], 0, 0, 0);   \
        o[d0] = __builtin_amdgcn_mfma_f32_32x32x16_bf16(pa2, (bf16x8){l2[0], l2[1], l2[2], l2[3], h2[0], h2[1], h2[2], h2[3]}, o[d0], 0, 0, 0);   \
        o[d0] = __builtin_amdgcn_mfma_f32_32x32x16_bf16(pa3, (bf16x8){l3[0], l3[1], l3[2], l3[3], h3[0], h3[1], h3[2], h3[3]}, o[d0], 0, 0, 0); } while (0)
    ATT_PV_D0(0); ATT_PV_D0(1); ATT_PV_D0(2); ATT_PV_D0(3);
#undef ATT_PV_D0
#undef ATT_TRRD
}

struct UnitIO { const bf16* Q; size_t q_rs; const bf16* K; size_t k_rs; const bf16* KR; const bf16* V; size_t v_rs; bf16* O; size_t o_rs;
                float* lse; size_t lse_rs; const bf16* O2; const bf16* O3; const float* lse2; const float* lse3; int nsteps, q0, kbase0, g0_active; };
template <int MODE>
__device__ __forceinline__ void attn_unit(lptr lds, const UnitIO& U) {
    constexpr int DQK = MODE == 0 ? 192 : 128, ND0 = DQK / 16, KSTR = DQK * 2;
    constexpr float SCALE = MODE == 0 ? 0.0721687836487032f : 0.0883883476483184f, C2 = 1.4426950408889634f * SCALE, THRR = 8.0f / SCALE;
    int tid_ = threadIdx.x; asm volatile("" : "+v"(tid_));
    const int tid = tid_, wid = __builtin_amdgcn_readfirstlane(tid >> 6), lane = tid & 63, r32 = lane & 31, hi = lane >> 5;
    const int g = wid >> 2, wq = wid & 3, tg = tid & 255;
    lptr Kt = lds + g * G_BYTES + KT_OFF; lptr Vt = lds + g * G_BYTES + VT_OFF;
    ALAS float* scr = (ALAS float*)(lds + SCR_OFF + wid * 512);
    const unsigned vb0 = (unsigned)(size_t)Vt + (unsigned)v_rd_base(lane);
    const bool act = (MODE == 0) || g == 1 || U.g0_active != 0;
    bf16x8 qr[ND0];
    { const bf16* qrow = U.Q + (size_t)(wq * 32 + r32) * U.q_rs + hi * 8;
#pragma unroll
      for (int d0 = 0; d0 < ND0; ++d0) qr[d0] = *(const bf16x8*)(qrow + d0 * 16); }
    const int srow = tg >> 4, sch = tg & 15, rrow = tg >> 3, rch = tg & 7;
    bf16x8 stK[4], stV[4], stR[2];
#define ATT_TILE(s) (MODE == 0 ? 2 * (s) + g : 2 * g + (s))
#define ATT_ISSUE(t) do { const long kb_ = (long)U.kbase0 + 64 * (t); \
        _Pragma("unroll") for (int i_ = 0; i_ < 4; ++i_) stK[i_] = *(const bf16x8*)(U.K + (size_t)(kb_ + srow + 16 * i_) * U.k_rs + sch * 8); \
        _Pragma("unroll") for (int i_ = 0; i_ < 4; ++i_) stV[i_] = *(const bf16x8*)(U.V + (size_t)(kb_ + srow + 16 * i_) * U.v_rs + sch * 8); \
        if (MODE == 0) { _Pragma("unroll") for (int i_ = 0; i_ < 2; ++i_) stR[i_] = *(const bf16x8*)(U.KR + (size_t)(kb_ + rrow + 32 * i_) * 64 + rch * 8); } } while (0)
#define ATT_WRITE() do { \
        _Pragma("unroll") for (int i_ = 0; i_ < 4; ++i_) { const int row_ = srow + 16 * i_; \
            *(ALAS bf16x8*)(Kt + row_ * KSTR + ((sch * 16) ^ (kswz<KSTR>(row_) << 4))) = stK[i_]; *(ALAS bf16x8*)(Vt + v_st(row_, sch * 8)) = stV[i_]; } \
        if (MODE == 0) { _Pragma("unroll") for (int i_ = 0; i_ < 2; ++i_) { const int row_ = rrow + 32 * i_; \
            *(ALAS bf16x8*)(Kt + row_ * KSTR + 256 + ((rch * 16) ^ (kswz<KSTR>(row_) << 4))) = stR[i_]; } } } while (0)
    float m_reg = -1e30f, l_reg = 0.f; f32x16 o[4];
#pragma unroll
    for (int d = 0; d < 4; ++d)
#pragma unroll
        for (int r = 0; r < 16; ++r) o[d][r] = 0.f;
    if (act) { ATT_ISSUE(ATT_TILE(0)); ASBAR(); ATT_WRITE(); }
    __syncthreads();
    const int qlo = U.q0 + wq * 32;
    const unsigned W = MODE == 0 ? 0x7fffffffu : 129u;
    for (int s = 0; s < U.nsteps; ++s) {
        const bool more = s + 1 < U.nsteps;
        if (more && act) ATT_ISSUE(ATT_TILE(s + 1));
        ASBAR();
        if (act) {
            const int kb = U.kbase0 + 64 * ATT_TILE(s);
            f32x16 p0, p1; qkt<ND0, KSTR>(p0, p1, Kt, r32, hi, qr);
            if (MODE != 0 || kb + 63 > qlo) mask_tile(p0, p1, qlo + r32 - 4 * hi - kb, W);
            float mn, alpha; partialSM(p0, p1, m_reg, mn, alpha, C2, THRR);
            bf16x8 pa0, pa1, pa2, pa3; finishSM(p0, p1, alpha, l_reg, pa0, pa1, pa2, pa3);
            if (__any(alpha < 1.f)) { if (hi == 0) scr[r32] = alpha; asm volatile("s_waitcnt lgkmcnt(0)" ::: "memory");
#pragma unroll
                for (int d = 0; d < 4; ++d)
#pragma unroll
                    for (int r = 0; r < 16; ++r) o[d][r] *= scr[crow(r, hi)]; }
            ASBAR();
            pv_tile(o, vb0, pa0, pa1, pa2, pa3);
        }
        __syncthreads();
        if (more && act) ATT_WRITE();
        __syncthreads();
    }
    ALAS float* OM = (ALAS float*)(lds + OM_OFF) + wq * 4096;
    ALAS float* ML = (ALAS float*)(lds + ML_OFF) + wq * 64;
    if (g == 1) {
#pragma unroll
        for (int d = 0; d < 4; ++d)
#pragma unroll
            for (int r = 0; r < 16; ++r) OM[crow(r, hi) * 128 + d * 32 + r32] = o[d][r];
        if (hi == 0) { ML[r32 * 2] = m_reg; ML[r32 * 2 + 1] = l_reg; }
    }
    __syncthreads();
    if (g == 0) {
        const float m1 = ML[r32 * 2], l1 = ML[r32 * 2 + 1];
        const float m = fmaxf(m_reg, m1), f0 = __builtin_amdgcn_exp2f((m_reg - m) * C2), f1 = __builtin_amdgcn_exp2f((m1 - m) * C2);
        const float L = l_reg * f0 + l1 * f1, inv = 1.0f / L;
        float ca = f0 * inv, cb = f1 * inv, c2 = 0.f, c3 = 0.f;
        if (MODE != 0) {
            const float lse1 = m * SCALE + logf(L);
            if (MODE == 1) { if (hi == 0) U.lse[(size_t)(wq * 32 + r32) * U.lse_rs] = lse1; }
            else { const float e2 = U.lse2[(size_t)(wq * 32 + r32) * U.lse_rs], e3 = U.lse3[(size_t)(wq * 32 + r32) * U.lse_rs];
                   const float mx = fmaxf(lse1, fmaxf(e2, e3)), w1 = expf(lse1 - mx), w2 = expf(e2 - mx), w3 = expf(e3 - mx), iz = 1.0f / (w1 + w2 + w3);
                   ca *= w1 * iz; cb *= w1 * iz; c2 = w2 * iz; c3 = w3 * iz; }
        }
        if (hi == 0) { scr[r32 * 4] = ca; scr[r32 * 4 + 1] = cb; scr[r32 * 4 + 2] = c2; scr[r32 * 4 + 3] = c3; }
        asm volatile("s_waitcnt lgkmcnt(0)" ::: "memory");
#pragma unroll
        for (int r = 0; r < 16; ++r) { const int row = crow(r, hi); const f32x4 cf = *(const ALAS f32x4*)(scr + row * 4);
            const size_t j = (size_t)(wq * 32 + row);
#pragma unroll
            for (int d = 0; d < 4; ++d) { float v = o[d][r] * cf[0] + OM[row * 128 + d * 32 + r32] * cf[1];
                if (MODE == 2) { const unsigned a2 = U.O2[j * U.q_rs + d * 32 + r32], a3 = U.O3[j * U.q_rs + d * 32 + r32];
                    v += cf[2] * __uint_as_float(a2 << 16) + cf[3] * __uint_as_float(a3 << 16); }
                const float vn = __shfl_xor(v, 1);
                if ((r32 & 1) == 0) *(unsigned*)(U.O + j * U.o_rs + d * 32 + r32) = cvtpk(v, vn); } }
    }
    __syncthreads();
#undef ATT_TILE
#undef ATT_ISSUE
#undef ATT_WRITE
}
}

static_assert(att::ATT_LDS_BYTES <= RING_BYTES, "attention scratch inside the ring region");
struct Frame { LAS unsigned char* lds; int G; };
struct Lane { int tid, lane, wave; };
__device__ __forceinline__ Lane get_lane() { int t = threadIdx.x; asm volatile("" : "+v"(t)); Lane L; L.tid = t; L.lane = t & 63; L.wave = __builtin_amdgcn_readfirstlane(t >> 6); return L; }
__device__ __forceinline__ float wave_sum(float v) {
#pragma unroll
    for (int o = 1; o < 64; o <<= 1) v += __shfl_xor(v, o);
    return v;
}
template <class MAP>
__device__ __forceinline__ void transpose_item(const float* W, int K, int N, const float* kscale, bf16* WT, const MAP& map, LAS float* scr, int item, int lane) {
    const int nblk = N / 32, kb = item / nblk, nb = item % nblk, k0 = 64 * kb, n0 = 32 * nb;
#pragma unroll 8
    for (int i = 0; i < 32; ++i) { const int kk = 2 * i + (lane >> 5); float v = W[(size_t)(k0 + kk) * N + n0 + (lane & 31)]; if (kscale) v *= kscale[k0 + kk]; scr[kk * 33 + (lane & 31)] = v; }
    LDS_WAIT(); asm volatile("" ::: "memory");
    const int c = lane & 7;
#pragma unroll
    for (int j = 0; j < 4; ++j) { const int n = (lane >> 3) + 8 * j; const LAS float* s = scr + (8 * c) * 33 + n;
        v4u o; o.x = pk2(s[0 * 33], s[1 * 33]); o.y = pk2(s[2 * 33], s[3 * 33]); o.z = pk2(s[4 * 33], s[5 * 33]); o.w = pk2(s[6 * 33], s[7 * 33]);
        *(GAS v4u*)(WT + (size_t)map(n0 + n) * K + k0 + 8 * c) = o; }
    LDS_WAIT(); asm volatile("" ::: "memory");
}
struct MapId { __device__ __forceinline__ int operator()(int j) const { return j; } };
struct MapGU { int up; __device__ __forceinline__ int operator()(int j) const { return (j >> 7) * 256 + up * 128 + (j & 127); } };
struct MapWin { __device__ __forceinline__ int operator()(int j) const {
    if (j < 1024) return j;
    if (j < 1088) { const int jj = j - 1024; return 16 * 256 + (jj >> 5) * 128 + (jj & 31); }
    if (j < 3136) { const int jj = j - 1088, which = jj >> 10, hh = (jj & 1023) >> 7, dim = jj & 127, t = hh >> 1, isB = hh & 1, tb = (4 + which * 4 + t) * 256;
        if (dim < 16) return tb + dim + 16 * isB;
        if (dim < 32) return tb + 128 + (dim - 16) + 16 * isB;
        return tb + isB * 128 + dim; }
    return 12 * 256 + (j - 3136); } };
struct MapUq { __device__ __forceinline__ int operator()(int j) const { const int head = j / 192, d = j - head * 192;
    if (d < 128) return (head >> 1) * 256 + (head & 1) * 128 + d;
    const int x2 = d >= 160, f = d - 128 - 32 * x2; return (4 + (head >> 2)) * 256 + x2 * 128 + 32 * (head & 3) + f; } };

__device__ __forceinline__ void sincos_d(double a, float& sn, float& cs) {
    const double TWO_PI = 6.283185307179586476925286766559, INV_2PI = 0.15915494309189533576888376337251;
    const double k = __builtin_rint(a * INV_2PI); const double r = __builtin_fma(-k, TWO_PI, a); const double z = r * r;
    double s = 1.13099628864477159e-31, c = -3.76998762881590539e-33;
#define HS(x) s = __builtin_fma(s, z, x)
#define HC(x) c = __builtin_fma(c, z, x)
    HS(-9.18368986379554601e-29); HS(6.44695028438447359e-26); HS(-3.86817017063068413e-23); HS(1.95729410633912626e-20); HS(-8.22063524662432950e-18); HS(2.81145725434552060e-15); HS(-7.64716373181981641e-13);
    HS(1.60590438368216133e-10); HS(-2.50521083854417202e-08); HS(2.75573192239858925e-06); HS(-1.98412698412698413e-04); HS(8.33333333333333322e-03); HS(-1.66666666666666657e-01); HS(1.0);
    HC(3.27988923706983776e-30); HC(-2.47959626322479759e-27); HC(1.61173757109611839e-24); HC(-8.89679139245057408e-22); HC(4.11031762331216484e-19); HC(-1.56192069685862253e-16); HC(4.77947733238738525e-14);
    HC(-1.14707455977297245e-11); HC(2.08767569878681002e-09); HC(-2.75573192239858883e-07); HC(2.48015873015873016e-05); HC(-1.38888888888888894e-03); HC(4.16666666666666644e-02); HC(-5.0e-01); HC(1.0);
#undef HS
#undef HC
    sn = (float)(s * r); cs = (float)c;
}
__device__ __forceinline__ void row_pass(const Frame& Fr, const float* xin, const float* Y, float coef, const float* gpost, const float* gpre, float* X, bf16* H) {
    const Lane F = get_lane();
    const int gw = blockIdx.x * NWAVES + F.wave, NGW = Fr.G * NWAVES;
    for (int row = gw; row < S; row += NGW) {
        const GAS f32x4* xr = (const GAS f32x4*)(xin + (size_t)row * DM) + F.lane;
        f32x4 x[8];
#pragma unroll
        for (int j = 0; j < 8; ++j) x[j] = xr[64 * j];
        if (Y) {
            const GAS f32x4* yr = (const GAS f32x4*)(Y + (size_t)row * DM) + F.lane; f32x4 y[8]; float s = 0.f;
#pragma unroll
            for (int j = 0; j < 8; ++j) { y[j] = yr[64 * j]; s += (y[j][0] * y[j][0] + y[j][1] * y[j][1]) + (y[j][2] * y[j][2] + y[j][3] * y[j][3]); }
            const float rs = coef / sqrtf(wave_sum(s) * (1.0f / DM) + 1e-6f);
#pragma unroll
            for (int j = 0; j < 8; ++j) { const f32x4 gp = *((const GAS f32x4*)gpost + F.lane + 64 * j); x[j] = x[j] + y[j] * gp * rs; }
        }
        GAS f32x4* xo = (GAS f32x4*)(X + (size_t)row * DM) + F.lane;
#pragma unroll
        for (int j = 0; j < 8; ++j) xo[64 * j] = x[j];
        if (gpre) {
            float s = 0.f;
#pragma unroll
            for (int j = 0; j < 8; ++j) s += (x[j][0] * x[j][0] + x[j][1] * x[j][1]) + (x[j][2] * x[j][2] + x[j][3] * x[j][3]);
            const float rs = 1.0f / sqrtf(wave_sum(s) * (1.0f / DM) + 1e-6f);
            GAS unsigned long long* ho = (GAS unsigned long long*)(H + (size_t)row * DM) + F.lane;
#pragma unroll
            for (int j = 0; j < 8; ++j) { const f32x4 gp = *((const GAS f32x4*)gpre + F.lane + 64 * j); const f32x4 h = x[j] * gp * rs;
                ho[64 * j] = (unsigned long long)pk2(h[0], h[1]) | ((unsigned long long)pk2(h[2], h[3]) << 32); }
        }
    }
}

struct Args { const float* in[20]; float* out; unsigned char* ws; int ph_lo, ph_hi; };
typedef const __attribute__((address_space(4))) Args* KArgs;
__device__ __forceinline__ KArgs get_args() { KArgs p = (KArgs)__builtin_amdgcn_kernarg_segment_ptr(); asm volatile("" : "+s"(p)); return p; }

__device__ __forceinline__ void phase_prologue(const Frame& Fr) {
    KArgs A = get_args(); unsigned char* ws = A->ws; const Lane F = get_lane();
    LAS float* scr = (LAS float*)(Fr.lds + RING_OFF + F.wave * 16384);
    const int gw = blockIdx.x * NWAVES + F.wave, NGW = Fr.G * NWAVES;
    constexpr int I_FF = (DM / 64) * (DFF / 32), I_IN = (DM / 64) * (NIN / 32), I_UQ = (512 / 64) * (1536 / 32), I_UKV = (512 / 64) * (2048 / 32), I_O = (DM / 64) * (DM / 32), I_Z = 192;
    constexpr int I_LAYER = 6 * I_FF + I_IN + I_UQ + I_UKV + I_O + I_Z;
    for (int it = gw; it < DEPTH * I_LAYER; it += NGW) {
        const int l = it / I_LAYER; int r = it - l * I_LAYER; unsigned char* wl = ws + WS_W + (size_t)l * W_LAYER;
        if (r < I_FF) { transpose_item(A->in[4] + (size_t)l * DM * DFF, DM, DFF, nullptr, (bf16*)(wl + WO_GU1), MapGU{0}, scr, r, F.lane); continue; } r -= I_FF;
        if (r < I_FF) { transpose_item(A->in[5] + (size_t)l * DM * DFF, DM, DFF, nullptr, (bf16*)(wl + WO_GU1), MapGU{1}, scr, r, F.lane); continue; } r -= I_FF;
        if (r < I_FF) { transpose_item(A->in[6] + (size_t)l * DFF * DM, DFF, DM, nullptr, (bf16*)(wl + WO_D1), MapId{}, scr, r, F.lane); continue; } r -= I_FF;
        if (r < I_FF) { transpose_item(A->in[17] + (size_t)l * DM * DFF, DM, DFF, nullptr, (bf16*)(wl + WO_GU2), MapGU{0}, scr, r, F.lane); continue; } r -= I_FF;
        if (r < I_FF) { transpose_item(A->in[18] + (size_t)l * DM * DFF, DM, DFF, nullptr, (bf16*)(wl + WO_GU2), MapGU{1}, scr, r, F.lane); continue; } r -= I_FF;
        if (r < I_FF) { transpose_item(A->in[19] + (size_t)l * DFF * DM, DFF, DM, nullptr, (bf16*)(wl + WO_D2), MapId{}, scr, r, F.lane); continue; } r -= I_FF;
        if (r < I_IN) { transpose_item(A->in[9] + (size_t)l * DM * NIN, DM, NIN, nullptr, (bf16*)(wl + WO_IN), MapWin{}, scr, r, F.lane); continue; } r -= I_IN;
        if (r < I_UQ) { transpose_item(A->in[11] + (size_t)l * 512 * 1536, 512, 1536, A->in[10] + l * 512, (bf16*)(wl + WO_UQ), MapUq{}, scr, r, F.lane); continue; } r -= I_UQ;
        if (r < I_UKV) { transpose_item(A->in[13] + (size_t)l * 512 * 2048, 512, 2048, A->in[12] + l * 512, (bf16*)(wl + WO_UKV), MapId{}, scr, r, F.lane); continue; } r -= I_UKV;
        if (r < I_O) { transpose_item(A->in[14] + (size_t)l * DM * DM, DM, DM, nullptr, (bf16*)(wl + WO_O), MapId{}, scr, r, F.lane); continue; } r -= I_O;
        { const int prow = 16 * 256 + (r / 96) * 128 + 32 + (r % 96);
          GAS v4u* z = (GAS v4u*)((bf16*)(wl + WO_IN) + (size_t)prow * DM) + F.lane;
#pragma unroll
          for (int j = 0; j < 4; ++j) z[64 * j] = (v4u){0u, 0u, 0u, 0u}; }
    }
    const int* pos = (const int*)A->in[1]; float* TA = (float*)(ws + WS_TA); float* TP = (float*)(ws + WS_TP);
    for (int i = blockIdx.x * (NWAVES * 64) + F.tid; i < S * 48; i += Fr.G * NWAVES * 64) {
        const int t = i / 48, f = i - t * 48; const bool part = f >= 32; const int fi = part ? f - 32 : f;
        const double ratio = part ? 4.40366602671780460465e-01 : 6.63601237696088475104e-01; double inv = 1.0;
        for (int k = 0; k < fi; ++k) inv *= ratio;
        float sn, cs; sincos_d((double)pos[t] * inv, sn, cs);
        if (part) { TP[(size_t)t * 32 + fi] = cs; TP[(size_t)t * 32 + 16 + fi] = sn; } else { TA[(size_t)t * 64 + fi] = cs; TA[(size_t)t * 64 + 32 + fi] = sn; }
    }
    row_pass(Fr, A->in[0], nullptr, 0.f, nullptr, A->in[2], A->out, (bf16*)(ws + WS_H));
}
__device__ __forceinline__ void phase_dilated12(const Frame& F) {
    KArgs A = get_args(); unsigned char* ws = A->ws;
    bf16* DQ = (bf16*)(ws + WS_DQ); bf16* DK = (bf16*)(ws + WS_DK); bf16* DV = (bf16*)(ws + WS_DV);
    for (int u = blockIdx.x; u < 1024; u += F.G) {
        const int pat = 1 + (u >> 9), uu = u & 511, h = uu & 7, bi = uu >> 3, d = pat == 1 ? 4 : 16, r = bi % d, n = bi / d;
        const size_t tok0 = (size_t)(128 * n) * d + r;
        att::UnitIO U; U.Q = DQ + tok0 * 1024 + h * 128; U.q_rs = (size_t)d * 1024; U.K = DK + (size_t)r * 1024 + h * 128; U.k_rs = (size_t)d * 1024; U.KR = nullptr;
        U.V = DV + (size_t)r * 1024 + h * 128; U.v_rs = (size_t)d * 1024; U.O = (bf16*)(ws + (pat == 1 ? WS_O2 : WS_O3)) + tok0 * 1024 + h * 128; U.o_rs = (size_t)d * 1024;
        U.lse = (float*)(ws + (pat == 1 ? WS_LSE2 : WS_LSE3)) + tok0 * 8 + h; U.lse_rs = (size_t)d * 8; U.O2 = nullptr; U.O3 = nullptr; U.lse2 = nullptr; U.lse3 = nullptr;
        U.nsteps = 2; U.q0 = 128 * n; U.kbase0 = 128 * (n - 1); U.g0_active = n > 0;
        att::attn_unit<1>(F.lds + RING_OFF, U);
    }
}
__device__ __forceinline__ void phase_mla(const Frame& F) {
    KArgs A = get_args(); unsigned char* ws = A->ws;
    for (int L = blockIdx.x; L < 256; L += F.G) {
        const int h = L & 7, x = L >> 3;
        for (int pass = 0; pass < 2; ++pass) { const int qb = pass ? x : 63 - x;
            att::UnitIO U; U.Q = (bf16*)(ws + WS_QA) + (size_t)(128 * qb) * 1536 + h * 192; U.q_rs = 1536; U.K = (bf16*)(ws + WS_KN) + h * 128; U.k_rs = 1024; U.KR = (bf16*)(ws + WS_KR);
            U.V = (bf16*)(ws + WS_VA) + h * 128; U.v_rs = 1024;
            U.O = (bf16*)(ws + WS_OCAT) + (size_t)(128 * qb) * 2048 + h * 128; U.o_rs = 2048; U.lse = nullptr; U.lse_rs = 0; U.O2 = nullptr; U.O3 = nullptr; U.lse2 = nullptr; U.lse3 = nullptr;
            U.nsteps = qb + 1; U.q0 = 128 * qb; U.kbase0 = 0; U.g0_active = 1;
            att::attn_unit<0>(F.lds + RING_OFF, U); }
    }
}
__device__ __forceinline__ void phase_dilated0(const Frame& F) {
    KArgs A = get_args(); unsigned char* ws = A->ws;
    for (int u = blockIdx.x; u < 512; u += F.G) {
        const int h = u & 7, n = u >> 3; const size_t tok0 = (size_t)128 * n;
        att::UnitIO U; U.Q = (bf16*)(ws + WS_DQ) + tok0 * 1024 + h * 128; U.q_rs = 1024; U.K = (bf16*)(ws + WS_DK) + h * 128; U.k_rs = 1024; U.KR = nullptr; U.V = (bf16*)(ws + WS_DV) + h * 128; U.v_rs = 1024;
        U.O = (bf16*)(ws + WS_OCAT) + tok0 * 2048 + 1024 + h * 128; U.o_rs = 2048; U.lse = nullptr; U.lse_rs = 8; U.O2 = (bf16*)(ws + WS_O2) + tok0 * 1024 + h * 128; U.O3 = (bf16*)(ws + WS_O3) + tok0 * 1024 + h * 128;
        U.lse2 = (float*)(ws + WS_LSE2) + tok0 * 8 + h; U.lse3 = (float*)(ws + WS_LSE3) + tok0 * 8 + h; U.nsteps = 2; U.q0 = 128 * n; U.kbase0 = 128 * (n - 1); U.g0_active = n > 0;
        att::attn_unit<2>(F.lds + RING_OFF, U);
    }
}

__global__ void __launch_bounds__(NWAVES * 64, 2) mk_fwd(Args args) {
    extern __shared__ __attribute__((aligned(16))) unsigned char lds_raw[];
    Frame F; F.lds = (LAS unsigned char*)lds_raw; F.G = gridDim.x;
    volatile LAS unsigned* MISC = (volatile LAS unsigned*)(F.lds + MISC_OFF);
    for (int u = threadIdx.x; u < (LDS_BYTES - LDSCTL_OFF) / 4; u += NWAVES * 64) ((LAS unsigned*)(F.lds + LDSCTL_OFF))[u] = 0u;
    __syncthreads();
    const int lo = args.ph_lo, hi = args.ph_hi;
    XcdBarrier bar; bar.bar = (unsigned*)(args.ws + WS_CTL) + CW_BAR; bar.x = 0; bar.st = nullptr;
    if (hi - lo > 1) bar = xcd_barrier_post((unsigned*)(args.ws + WS_CTL) + CW_BAR, MISC + 8);
    int ph = 0;
#define IN_PH() (ph >= lo && ph < hi)
#define SEAM() do { if (ph >= lo && ph + 1 < hi) xcd_barrier(bar); ++ph; } while (0)

    if (IN_PH()) phase_prologue(F);
    SEAM();

    for (int l = 0; l < DEPTH; ++l) {
        for (int s3 = 0; s3 < 3; ++s3) {
            if (s3 != 1) {
                const int f2 = s3 >> 1;
                if (IN_PH()) { KArgs A = get_args(); unsigned char* ws = A->ws; unsigned char* wl = ws + WS_W + (size_t)l * W_LAYER;
                    pg8::Gemm g{(const bf16*)(ws + WS_H), (const bf16*)(wl + (f2 ? WO_GU2 : WO_GU1)), S, 2 * DFF, DM}; pg8::StaticOrder SO; SO.init(S, 2 * DFF, F.G, (int)blockIdx.x); pg8::EpiSwiGLU E{(bf16*)(ws + WS_ACT), DFF};
                    pg8::gemm_phase<pg8::EpiSwiGLU, pg8::StaticOrder, true, true>(F.lds + RING_OFF, g, SO, E); }
                SEAM();
                if (IN_PH()) { KArgs A = get_args(); unsigned char* ws = A->ws; unsigned char* wl = ws + WS_W + (size_t)l * W_LAYER;
                    pg8::Gemm g{(const bf16*)(ws + WS_ACT), (const bf16*)(wl + (f2 ? WO_D2 : WO_D1)), S, DM, DFF}; pg8::StaticOrder SO; SO.init(S, DM, F.G, (int)blockIdx.x); pg8::EpiF32 E{(float*)(ws + WS_Y), DM};
                    pg8::gemm_phase<pg8::EpiF32, pg8::StaticOrder, true, true>(F.lds + RING_OFF, g, SO, E); }
                SEAM();
                if (IN_PH()) { KArgs A = get_args(); unsigned char* ws = A->ws;
                    const float* gpost = A->in[f2 ? 16 : 3] + l * DM; const float* gpre = f2 ? (l + 1 < DEPTH ? A->in[2] + (l + 1) * DM : nullptr) : A->in[7] + l * DM;
                    row_pass(F, A->out, (const float*)(ws + WS_Y), 0.5f, gpost, gpre, A->out, (bf16*)(ws + WS_H)); }
                SEAM();
            } else {
                if (IN_PH()) { KArgs A = get_args(); unsigned char* ws = A->ws; unsigned char* wl = ws + WS_W + (size_t)l * W_LAYER;
                    pg8::Gemm g{(const bf16*)(ws + WS_H), (const bf16*)(wl + WO_IN), S, NIN_PHYS, DM}; pg8::StaticOrder SO; SO.init(S, NIN_PHYS, F.G, (int)blockIdx.x); pg8::EpiWin E{ws};
                    pg8::gemm_phase<pg8::EpiWin, pg8::StaticOrder, true, true>(F.lds + RING_OFF, g, SO, E); }
                SEAM();
                if (IN_PH()) {
                    { KArgs A = get_args(); unsigned char* ws = A->ws; unsigned char* wl = ws + WS_W + (size_t)l * W_LAYER;
                      pg8::Gemm g{(const bf16*)(ws + WS_CQ), (const bf16*)(wl + WO_UQ), S, 1536, 512}; pg8::StaticOrder SO; SO.init(S, 1536, F.G, (int)blockIdx.x); pg8::EpiUq E{ws};
                      pg8::gemm_phase<pg8::EpiUq, pg8::StaticOrder, true, true>(F.lds + RING_OFF, g, SO, E); }
                    { KArgs A = get_args(); unsigned char* ws = A->ws; unsigned char* wl = ws + WS_W + (size_t)l * W_LAYER;
                      pg8::Gemm g{(const bf16*)(ws + WS_CKV), (const bf16*)(wl + WO_UKV), S, 2048, 512}; pg8::StaticOrder SO; SO.init(S, 2048, F.G, (int)((blockIdx.x + 64u) % (unsigned)F.G)); pg8::EpiUkv E{ws};
                      pg8::gemm_phase<pg8::EpiUkv, pg8::StaticOrder, true, true>(F.lds + RING_OFF, g, SO, E); }
                    phase_dilated12(F);
                }
                SEAM();
                if (IN_PH()) { phase_mla(F); phase_dilated0(F); }
                SEAM();
                if (IN_PH()) { KArgs A = get_args(); unsigned char* ws = A->ws; unsigned char* wl = ws + WS_W + (size_t)l * W_LAYER;
                    pg8::Gemm g{(const bf16*)(ws + WS_OCAT), (const bf16*)(wl + WO_O), S, DM, DM}; pg8::StaticOrder SO; SO.init(S, DM, F.G, (int)blockIdx.x); pg8::EpiF32 E{(float*)(ws + WS_Y), DM};
                    pg8::gemm_phase<pg8::EpiF32, pg8::StaticOrder, true, true>(F.lds + RING_OFF, g, SO, E); }
                SEAM();
                if (IN_PH()) { KArgs A = get_args(); unsigned char* ws = A->ws; row_pass(F, A->out, (const float*)(ws + WS_Y), 1.0f, A->in[8] + l * DM, A->in[15] + l * DM, A->out, (bf16*)(ws + WS_H)); }
                SEAM();
            }
        }
    }
#undef IN_PH
#undef SEAM
}
extern "C" void kernel_launch(void* const* d_in, const int* in_sizes, int n_in, void* d_out, int out_size, void* d_ws, size_t ws_size, hipStream_t stream) {
    static int grid = 0;
    if (grid == 0) {
        if (n_in != 20 || in_sizes[0] != S * DM || out_size != S * DM || ws_size < WS_END) { fprintf(stderr, "kernel_launch: unexpected shapes (n_in %d, in0 %d, out %d, ws %zu < %zu); nothing launched\n", n_in, n_in > 0 ? in_sizes[0] : -1, out_size, ws_size, (size_t)WS_END); grid = -1; return; }
        int dev = 0, cus = 0, per_cu = 0;
        if (hipGetDevice(&dev) != hipSuccess || hipDeviceGetAttribute(&cus, hipDeviceAttributeMultiprocessorCount, dev) != hipSuccess) { fprintf(stderr, "kernel_launch: device query failed\n"); grid = -1; return; }
        if (hipFuncSetAttribute((const void*)mk_fwd, hipFuncAttributeMaxDynamicSharedMemorySize, LDS_BYTES) != hipSuccess) { fprintf(stderr, "kernel_launch: hipFuncSetAttribute failed\n"); grid = -1; return; }
        if (hipOccupancyMaxActiveBlocksPerMultiprocessor(&per_cu, (const void*)mk_fwd, NWAVES * 64, LDS_BYTES) != hipSuccess || per_cu < 1) { fprintf(stderr, "kernel_launch: occupancy query reports %d workgroups per CU\n", per_cu); }
        (void)hipGetLastError();
        grid = cus;
    }
    if (grid < 0) return;
    if (hipMemsetAsync((char*)d_ws + WS_CTL, 0, CTL_ZERO_BYTES, stream) != hipSuccess) { fprintf(stderr, "kernel_launch: memset failed\n"); return; }
    Args a{};
    for (int i = 0; i < 20; ++i) a.in[i] = (const float*)d_in[i];
    a.out = (float*)d_out; a.ws = (unsigned char*)d_ws;
#if MK_SINGLE_LAUNCH
    a.ph_lo = 0; a.ph_hi = N_PHASES;
    hipLaunchKernelGGL(mk_fwd, dim3(grid), dim3(NWAVES * 64), LDS_BYTES, stream, a);
#else
    for (int p = 0; p < N_PHASES; ++p) { a.ph_lo = p; a.ph_hi = p + 1; hipLaunchKernelGGL(mk_fwd, dim3(grid), dim3(NWAVES * 64), LDS_BYTES, stream, a); }
#endif
    const hipError_t le = hipPeekAtLastError();
    if (le != hipSuccess) fprintf(stderr, "kernel_launch: launch failed: %s\n", hipGetErrorName(le));
}
```

```cpp
#include <hip/hip_runtime.h>
#include <cstdio>
#include <cstdint>
constexpr int S = 8192, DM = 2048, DFF = 5632, DEPTH = 4, NIN_PHYS = 4352  , NIN = 4160;
constexpr int NWAVES = 8;
#ifndef MK_SINGLE_LAUNCH
#define MK_SINGLE_LAUNCH 1
#endif
constexpr int N_PHASES = 1 + DEPTH * 11;
constexpr size_t MiB = 1u << 20;
constexpr size_t WS_CTL = 0, CTL_ZERO_BYTES = 1 * MiB;
constexpr size_t WS_TA = 1 * MiB, WS_TP = 3 * MiB, WS_SSQQ = 4 * MiB, WS_SSQKV = 4 * MiB + 256 * 1024, WS_LSE2 = 4 * MiB + 512 * 1024, WS_LSE3 = 4 * MiB + 768 * 1024, WS_KR = 5 * MiB;
constexpr size_t WS_H = 8 * MiB, WS_ACT = 40 * MiB, WS_Y = 128 * MiB, WS_CQ = 192 * MiB, WS_CKV = 200 * MiB, WS_DQ = 208 * MiB, WS_DK = 224 * MiB, WS_DV = 240 * MiB;
constexpr size_t WS_QA = 256 * MiB, WS_KN = 280 * MiB, WS_VA = 296 * MiB, WS_OCAT = 312 * MiB, WS_O2 = 344 * MiB, WS_O3 = 360 * MiB, WS_W = 384 * MiB;
constexpr size_t W_GU = (size_t)2 * DFF * DM * 2, W_D = (size_t)DM * DFF * 2, W_IN = (size_t)NIN_PHYS * DM * 2, W_UQ = (size_t)1536 * 512 * 2, W_UKV = (size_t)2048 * 512 * 2, W_O = (size_t)DM * DM * 2;
constexpr size_t WO_GU1 = 0, WO_D1 = WO_GU1 + W_GU, WO_IN = WO_D1 + W_D, WO_UQ = WO_IN + W_IN, WO_UKV = WO_UQ + W_UQ, WO_O = WO_UKV + W_UKV, WO_GU2 = WO_O + W_O, WO_D2 = WO_GU2 + W_GU, W_LAYER = WO_D2 + W_D;
constexpr size_t WS_END = WS_W + DEPTH * W_LAYER;
static_assert(W_LAYER % 256 == 0 && (size_t)S * DFF * 2 <= WS_Y - WS_ACT && (size_t)S * DM * 4 <= WS_CQ - WS_Y, "d_ws map");
constexpr int CW_BAR = 4096;
constexpr int RING_OFF = 0, RING_BYTES = 131072, LDSCTL_OFF = RING_BYTES, MISC_OFF = LDSCTL_OFF + 320, LDS_BYTES = 147456;

namespace pg8 {
#define PG8_LAS __attribute__((address_space(3)))
typedef unsigned short bf16_t;
typedef short bf16x8 __attribute__((ext_vector_type(8)));
typedef float f32x4 __attribute__((ext_vector_type(4)));
typedef unsigned u32x4 __attribute__((ext_vector_type(4)));
constexpr int BM = 256, BK = 64, HALF = 128, HTB = HALF * BK * 2  , STAGE_BYTES = 8 * HTB, NXCD = 8, WGM = 8;

__host__ __device__ __forceinline__ int lds_byte(int r, int c) { const int st = (r >> 4) * 2 + (c >> 5), rr = r & 15, cc = c & 31, ob = rr * 64 + cc * 2; return st * 1024 + (ob ^ (((ob >> 9) & 1) << 5)); }
__host__ __device__ __forceinline__ void stage_rc(int b, int& R, int& C) { const int st = b / 1024, sb = b % 1024, swz = sb ^ (((sb >> 9) & 1) << 5); R = (st >> 1) * 16 + swz / 64; C = (st & 1) * 32 + (swz % 64) / 2; }
__host__ __device__ __forceinline__ int perm32(int rho) { const int n = rho >> 4, i = rho & 15; return 8 * (i >> 2) + 4 * n + (i & 3); }

struct Unit { int pm, pn; };
struct Gemm { const bf16_t* A; const bf16_t* Bt; int M, N, K; };

struct StaticOrder {
    int nM, nN, nwg, G, c;
    __host__ __device__ void init(int M, int N, int G_, int c_) { nM = M / BM; nN = N / BM; nwg = nM * nN; G = G_; c = c_; }
    __host__ __device__ bool next(int i, Unit& u) const {
        const long L = (long)i * G + c; if (L >= nwg) return false;
        int wgid = (int)L; { const int q = nwg / NXCD, r = nwg % NXCD, xcd = wgid % NXCD, off = wgid / NXCD; wgid = (xcd < r ? xcd * (q + 1) : r * (q + 1) + (xcd - r) * q) + off; }
        const int nig = WGM * nN, gid = wgid / nig, fm = gid * WGM, gsz = (nM - fm) < WGM ? (nM - fm) : WGM;
        u.pm = fm + ((wgid % nig) % gsz); u.pn = (wgid % nig) / gsz; return true;
    }
    __device__ __forceinline__ void a_ready(const Unit&) const {}
    __device__ __forceinline__ void done(const Unit&) const {}
};

__device__ __forceinline__ unsigned cvt_pk_bf16(float lo, float hi) { unsigned r; asm volatile("v_cvt_pk_bf16_f32 %0, %1, %2" : "=v"(r) : "v"(lo), "v"(hi)); return r; }
typedef float f32x2 __attribute__((ext_vector_type(2)));
__device__ __forceinline__ u32x4 pack8f(f32x4 a, f32x4 b) { u32x4 w; w.x = cvt_pk_bf16(a[0], a[1]); w.y = cvt_pk_bf16(a[2], a[3]); w.z = cvt_pk_bf16(b[0], b[1]); w.w = cvt_pk_bf16(b[2], b[3]); return w; }
__device__ __forceinline__ float silu_mul(float g, float u) { const float e = __builtin_amdgcn_exp2f(-1.4426950408889634f * g); return g * u * __builtin_amdgcn_rcpf(1.0f + e); }
constexpr float RMS_EPS_F = 1e-6f;

struct EpiF32 {
    static constexpr bool PERM = false, AFTER_DRAIN = false;
    float* C; int ldc;
    __device__ __forceinline__ void operator()(const f32x4 (&acc)[2][2][4][2], const Unit& u, int wr, int wc, int fr, int fq) const {
        const int row0 = u.pm * BM + wr * 64 + fr, col0 = u.pn * BM + wc * 32 + 4 * fq;
#pragma unroll
        for (int ai = 0; ai < 2; ++ai)
#pragma unroll
            for (int m = 0; m < 4; ++m) { float* rowp = C + (size_t)(row0 + ai * HALF + m * 16) * ldc + col0;
#pragma unroll
                for (int bj = 0; bj < 2; ++bj)
#pragma unroll
                    for (int n = 0; n < 2; ++n) *(f32x4*)(rowp + bj * HALF + n * 16) = acc[ai][bj][m][n]; }
    }
};
struct EpiSwiGLU {
    static constexpr bool PERM = true, AFTER_DRAIN = false;
    bf16_t* O; int ldc;
    __device__ __forceinline__ void operator()(const f32x4 (&acc)[2][2][4][2], const Unit& u, int wr, int wc, int fr, int fq) const {
        const int row0 = u.pm * BM + wr * 64 + fr, col0 = u.pn * HALF + wc * 32 + 8 * fq;
#pragma unroll
        for (int ai = 0; ai < 2; ++ai)
#pragma unroll
            for (int m = 0; m < 4; ++m) { bf16_t* rowp = O + (size_t)(row0 + ai * HALF + m * 16) * ldc + col0; f32x4 r0, r1;
#pragma unroll
                for (int j = 0; j < 4; ++j) { r0[j] = silu_mul(acc[ai][0][m][0][j], acc[ai][1][m][0][j]); r1[j] = silu_mul(acc[ai][0][m][1][j], acc[ai][1][m][1][j]); }
                *(u32x4*)rowp = pack8f(r0, r1); }
    }
};
struct EpiWin {
    static constexpr bool PERM = true, AFTER_DRAIN = false;
    unsigned char* ws;
    __device__ __forceinline__ void operator()(const f32x4 (&acc)[2][2][4][2], const Unit& u, int wr, int wc, int fr, int fq) const {
        bf16_t* const CQ = (bf16_t*)(ws + WS_CQ); bf16_t* const CKV = (bf16_t*)(ws + WS_CKV); bf16_t* const DQ = (bf16_t*)(ws + WS_DQ); bf16_t* const DK = (bf16_t*)(ws + WS_DK); bf16_t* const DV = (bf16_t*)(ws + WS_DV); bf16_t* const KR = (bf16_t*)(ws + WS_KR);
        float* const SSQ_Q = (float*)(ws + WS_SSQQ); float* const SSQ_KV = (float*)(ws + WS_SSQKV); const float* const TA = (const float*)(ws + WS_TA); const float* const TP = (const float*)(ws + WS_TP);
        const int row0 = u.pm * BM + wr * 64 + fr, pn = u.pn;
        if (pn < 4) {
            bf16_t* dst = pn < 2 ? CQ : CKV; float* ssq = pn < 2 ? SSQ_Q : SSQ_KV; const int colt = (pn & 1) * 256 + wc * 32 + 8 * fq;
#pragma unroll
            for (int ai = 0; ai < 2; ++ai)
#pragma unroll
                for (int m = 0; m < 4; ++m) { const int row = row0 + ai * HALF + m * 16; float s = 0.f;
#pragma unroll
                    for (int bj = 0; bj < 2; ++bj) { const f32x4 v0 = acc[ai][bj][m][0], v1 = acc[ai][bj][m][1];
                        s += (v0[0] * v0[0] + v0[1] * v0[1]) + (v0[2] * v0[2] + v0[3] * v0[3]) + (v1[0] * v1[0] + v1[1] * v1[1]) + (v1[2] * v1[2] + v1[3] * v1[3]);
                        *(u32x4*)(dst + (size_t)row * 512 + colt + bj * HALF) = pack8f(v0, v1); }
                    s += __shfl_xor(s, 16); s += __shfl_xor(s, 32);
                    if (fq == 0) ssq[(size_t)row * 8 + (pn & 1) * 4 + wc] = s; }
        } else if (pn < 12) {
            bf16_t* dst = pn < 8 ? DQ : DK; const int t = (pn - 4) & 3;
            if (wc == 0) {
                const int head = 2 * t + (fq >> 1), f0 = 8 * (fq & 1);
#pragma unroll
                for (int ai = 0; ai < 2; ++ai)
#pragma unroll
                    for (int m = 0; m < 4; ++m) { const int row = row0 + ai * HALF + m * 16; const float* tp = TP + (size_t)row * 32 + f0;
                        const f32x4 c0 = *(const f32x4*)tp, c1 = *(const f32x4*)(tp + 4), s0 = *(const f32x4*)(tp + 16), s1 = *(const f32x4*)(tp + 20);
                        const f32x4 x1a = acc[ai][0][m][0], x1b = acc[ai][0][m][1], x2a = acc[ai][1][m][0], x2b = acc[ai][1][m][1];
                        bf16_t* o = dst + (size_t)row * 1024 + head * 128 + f0;
                        *(u32x4*)o = pack8f(x1a * c0 - x2a * s0, x1b * c1 - x2b * s1);
                        *(u32x4*)(o + 16) = pack8f(x2a * c0 + x1a * s0, x2b * c1 + x1b * s1); }
            } else {
                const int q = wc * 32 + 8 * fq;
#pragma unroll
                for (int ai = 0; ai < 2; ++ai)
#pragma unroll
                    for (int m = 0; m < 4; ++m) { const int row = row0 + ai * HALF + m * 16;
#pragma unroll
                        for (int bj = 0; bj < 2; ++bj) *(u32x4*)(dst + (size_t)row * 1024 + (2 * t + bj) * 128 + q) = pack8f(acc[ai][bj][m][0], acc[ai][bj][m][1]); }
            }
        } else if (pn < 16) {
            const int colt = (pn - 12) * 256 + wc * 32 + 8 * fq;
#pragma unroll
            for (int ai = 0; ai < 2; ++ai)
#pragma unroll
                for (int m = 0; m < 4; ++m) { const int row = row0 + ai * HALF + m * 16;
#pragma unroll
                    for (int bj = 0; bj < 2; ++bj) *(u32x4*)(DV + (size_t)row * 1024 + colt + bj * HALF) = pack8f(acc[ai][bj][m][0], acc[ai][bj][m][1]); }
        } else {
            if (wc == 0) {
                const int f0 = 8 * fq;
#pragma unroll
                for (int ai = 0; ai < 2; ++ai)
#pragma unroll
                    for (int m = 0; m < 4; ++m) { const int row = row0 + ai * HALF + m * 16; const float* ta = TA + (size_t)row * 64 + f0;
                        const f32x4 c0 = *(const f32x4*)ta, c1 = *(const f32x4*)(ta + 4), s0 = *(const f32x4*)(ta + 32), s1 = *(const f32x4*)(ta + 36);
                        const f32x4 x1a = acc[ai][0][m][0], x1b = acc[ai][0][m][1], x2a = acc[ai][1][m][0], x2b = acc[ai][1][m][1];
                        bf16_t* o = KR + (size_t)row * 64 + f0;
                        *(u32x4*)o = pack8f(x1a * c0 - x2a * s0, x1b * c1 - x2b * s1);
                        *(u32x4*)(o + 32) = pack8f(x2a * c0 + x1a * s0, x2b * c1 + x1b * s1); }
            }
        }
    }
};
__device__ __forceinline__ float row_rs512(const float* ssq, int row) { const f32x4 a = *(const f32x4*)(ssq + (size_t)row * 8), b = *(const f32x4*)(ssq + (size_t)row * 8 + 4);
    const float s = ((a[0] + a[1]) + (a[2] + a[3])) + ((b[0] + b[1]) + (b[2] + b[3])); return 1.0f / sqrtf(s * (1.0f / 512.0f) + RMS_EPS_F); }
struct EpiUq {
    static constexpr bool PERM = true, AFTER_DRAIN = false;
    unsigned char* ws;
    __device__ __forceinline__ void operator()(const f32x4 (&acc)[2][2][4][2], const Unit& u, int wr, int wc, int fr, int fq) const {
        bf16_t* const QA = (bf16_t*)(ws + WS_QA); const float* const SSQ = (const float*)(ws + WS_SSQQ); const float* const TA = (const float*)(ws + WS_TA);
        const int row0 = u.pm * BM + wr * 64 + fr, pn = u.pn;
#pragma unroll
        for (int ai = 0; ai < 2; ++ai)
#pragma unroll
            for (int m = 0; m < 4; ++m) { const int row = row0 + ai * HALF + m * 16; const float rs = row_rs512(SSQ, row);
                if (pn < 4) {
#pragma unroll
                    for (int bj = 0; bj < 2; ++bj) *(u32x4*)(QA + (size_t)row * 1536 + (2 * pn + bj) * 192 + wc * 32 + 8 * fq) = pack8f(acc[ai][bj][m][0] * rs, acc[ai][bj][m][1] * rs);
                } else {
                    const int head = 4 * (pn - 4) + wc, f0 = 8 * fq; const float* ta = TA + (size_t)row * 64 + f0;
                    const f32x4 c0 = *(const f32x4*)ta, c1 = *(const f32x4*)(ta + 4), s0 = *(const f32x4*)(ta + 32), s1 = *(const f32x4*)(ta + 36);
                    const f32x4 x1a = acc[ai][0][m][0] * rs, x1b = acc[ai][0][m][1] * rs, x2a = acc[ai][1][m][0] * rs, x2b = acc[ai][1][m][1] * rs;
                    bf16_t* o = QA + (size_t)row * 1536 + head * 192 + 128 + f0;
                    *(u32x4*)o = pack8f(x1a * c0 - x2a * s0, x1b * c1 - x2b * s1);
                    *(u32x4*)(o + 32) = pack8f(x2a * c0 + x1a * s0, x2b * c1 + x1b * s1);
                } }
    }
};
struct EpiUkv {
    static constexpr bool PERM = true, AFTER_DRAIN = false;
    unsigned char* ws;
    __device__ __forceinline__ void operator()(const f32x4 (&acc)[2][2][4][2], const Unit& u, int wr, int wc, int fr, int fq) const {
        bf16_t* const KN = (bf16_t*)(ws + WS_KN); bf16_t* const VA = (bf16_t*)(ws + WS_VA); const float* const SSQ = (const float*)(ws + WS_SSQKV);
        const int row0 = u.pm * BM + wr * 64 + fr, col = u.pn * 128 + wc * 32 + 8 * fq;
#pragma unroll
        for (int ai = 0; ai < 2; ++ai)
#pragma unroll
            for (int m = 0; m < 4; ++m) { const int row = row0 + ai * HALF + m * 16; const float rs = row_rs512(SSQ, row);
                *(u32x4*)(KN + (size_t)row * 1024 + col) = pack8f(acc[ai][0][m][0] * rs, acc[ai][0][m][1] * rs);
                *(u32x4*)(VA + (size_t)row * 1024 + col) = pack8f(acc[ai][1][m][0] * rs, acc[ai][1][m][1] * rs); }
    }
};

template <class Epi, class Sched, bool ALIGN_EPI = false, bool SP2 = false>
__device__ __forceinline__ void gemm_phase(PG8_LAS unsigned char* lds, const Gemm g, const Sched& S, const Epi& E) {
    int tid_ = threadIdx.x; asm volatile("" : "+v"(tid_));
    const int tid = tid_, wid = __builtin_amdgcn_readfirstlane(tid >> 6), lane = tid & 63, wr = wid >> 2, wc = wid & 3, fr = lane & 15, fq = lane >> 4;
    const int K = g.K, nt = K / BK;
    unsigned voffA[2], voffB[2];
#pragma unroll
    for (int i = 0; i < 2; ++i) { int R, C; stage_rc(tid * 16 + i * 8192, R, C); const int Rb = Epi::PERM ? ((R & ~31) + perm32(R & 31)) : R;
        voffA[i] = (unsigned)(R * K + C) * 2u; voffB[i] = (unsigned)(Rb * K + C) * 2u; }
    const size_t kstep = (size_t)(BK * 2);
    const size_t hstep = (size_t)HALF * K * 2;
    const size_t tstep = 2 * hstep;
    const unsigned ldsw = (unsigned)wid * 1024u;
    const int aoff = lds_byte(wr * 64 + fr, fq * 8), boff = lds_byte(wc * 32 + fr, fq * 8);
#define PG8_SA(b, h) (((b) * 2 + (h)) * HTB)
#define PG8_SB(b, h) ((4 + (b) * 2 + (h)) * HTB)
#define PG8_STAGE(bufoff, gbase, voff) do { _Pragma("unroll") for (int _i = 0; _i < 2; ++_i) \
        __builtin_amdgcn_global_load_lds((const unsigned*)((const char*)(gbase) + (voff)[_i]), (PG8_LAS unsigned*)(lds + (bufoff) + ldsw + _i * 8192), 16, 0, 0); } while (0)
#define PG8_LDA(dst, b, h) do { _Pragma("unroll") for (int m = 0; m < 4; ++m) _Pragma("unroll") for (int k = 0; k < 2; ++k) dst[m][k] = *(const PG8_LAS bf16x8*)(lds + PG8_SA(b, h) + aoff + m * 2048 + k * 1024); } while (0)
#define PG8_LDB(dst, b, h) do { _Pragma("unroll") for (int n = 0; n < 2; ++n) _Pragma("unroll") for (int k = 0; k < 2; ++k) dst[n][k] = *(const PG8_LAS bf16x8*)(lds + PG8_SB(b, h) + boff + n * 2048 + k * 1024); } while (0)
#define PG8_MMA(ai, bj, At, Bt) do { __builtin_amdgcn_s_setprio(1); _Pragma("unroll") for (int m = 0; m < 4; ++m) _Pragma("unroll") for (int n = 0; n < 2; ++n) _Pragma("unroll") for (int k = 0; k < 2; ++k) \
        acc[ai][bj][m][n] = __builtin_amdgcn_mfma_f32_16x16x32_bf16(Bt[n][k], At[m][k], acc[ai][bj][m][n], 0, 0, 0); __builtin_amdgcn_s_setprio(0); } while (0)
#define PG8_WAIT_V(n) asm volatile("s_waitcnt vmcnt(" #n ")" ::: "memory")
#define PG8_WAIT_L(n) asm volatile("s_waitcnt lgkmcnt(" #n ")" ::: "memory")
#define PG8_BAR __builtin_amdgcn_s_barrier()
#define PG8_SCHED __builtin_amdgcn_sched_barrier(0)
    Unit cur, nxt; int ui = 0;
    if (!S.next(0, cur)) return;
    f32x4 acc[2][2][4][2];
#pragma unroll
    for (int a = 0; a < 2; ++a)
#pragma unroll
        for (int b = 0; b < 2; ++b)
#pragma unroll
            for (int m = 0; m < 4; ++m)
#pragma unroll
                for (int n = 0; n < 2; ++n) acc[a][b][m][n] = (f32x4){0.f, 0.f, 0.f, 0.f};
    bf16x8 At[4][2], B0[2][2], B1[2][2];
    const char* cA = (const char*)g.A + (size_t)cur.pm * tstep; const char* cB = (const char*)g.Bt + (size_t)cur.pn * tstep;
    S.a_ready(cur);
    if constexpr (SP2) {
        PG8_STAGE(PG8_SB(0, 0), cB, voffB); PG8_STAGE(PG8_SB(0, 1), cB + hstep, voffB); PG8_STAGE(PG8_SA(0, 0), cA, voffA); PG8_STAGE(PG8_SA(0, 1), cA + hstep, voffA);
        if (wr == 1) PG8_BAR;
        PG8_WAIT_V(2); PG8_BAR;
        PG8_STAGE(PG8_SB(1, 0), cB + kstep, voffB); PG8_STAGE(PG8_SA(1, 0), cA + kstep, voffA); PG8_STAGE(PG8_SB(1, 1), cB + hstep + kstep, voffB);
        PG8_WAIT_V(6); PG8_BAR;
    } else {
        PG8_STAGE(PG8_SB(0, 0), cB, voffB); PG8_STAGE(PG8_SA(0, 0), cA, voffA); PG8_STAGE(PG8_SB(0, 1), cB + hstep, voffB); PG8_STAGE(PG8_SA(0, 1), cA + hstep, voffA);
        if (wr == 1) PG8_BAR;
        PG8_WAIT_V(4); PG8_BAR;
        PG8_STAGE(PG8_SB(1, 0), cB + kstep, voffB); PG8_STAGE(PG8_SA(1, 0), cA + kstep, voffA); PG8_STAGE(PG8_SB(1, 1), cB + hstep + kstep, voffB);
        PG8_WAIT_V(6); PG8_BAR;
    }
    for (;;) {
        const bool has_next = S.next(ui + 1, nxt);
        const char* nA = has_next ? (const char*)g.A + (size_t)nxt.pm * tstep : cA; const char* nB = has_next ? (const char*)g.Bt + (size_t)nxt.pn * tstep : cB;
        for (int t = 0; t < nt; t += 2) {
            const bool last = (t == nt - 2);
            const char* a1 = cA + (size_t)(t + 1) * kstep;
            const char* a2 = last ? nA : cA + (size_t)(t + 2) * kstep; const char* b2 = last ? nB : cB + (size_t)(t + 2) * kstep;
            const char* a3 = a2 + kstep; const char* b3 = b2 + kstep;
            if (last && has_next) S.a_ready(nxt);
            if constexpr (SP2) {
            PG8_LDB(B0, 0, 0); PG8_LDB(B1, 0, 1); PG8_SCHED; PG8_LDA(At, 0, 0); PG8_STAGE(PG8_SA(1, 1), a1 + hstep, voffA);
            PG8_WAIT_V(8); PG8_WAIT_L(0); PG8_BAR; PG8_MMA(0, 0, At, B0); PG8_MMA(0, 1, At, B1); PG8_BAR; PG8_SCHED;
            PG8_LDA(At, 0, 1); PG8_STAGE(PG8_SB(0, 0), b2, voffB); PG8_STAGE(PG8_SB(0, 1), b2 + hstep, voffB); PG8_STAGE(PG8_SA(0, 0), a2, voffA);
            PG8_WAIT_V(8); PG8_WAIT_L(0); PG8_BAR; PG8_MMA(1, 0, At, B0); PG8_MMA(1, 1, At, B1); PG8_BAR; PG8_SCHED;
            PG8_LDB(B0, 1, 0); PG8_LDB(B1, 1, 1); PG8_SCHED; PG8_LDA(At, 1, 0); PG8_STAGE(PG8_SA(0, 1), a2 + hstep, voffA);
            PG8_WAIT_V(8); PG8_WAIT_L(0); PG8_BAR; PG8_MMA(0, 0, At, B0); PG8_MMA(0, 1, At, B1); PG8_BAR; PG8_SCHED;
            PG8_LDA(At, 1, 1); PG8_STAGE(PG8_SB(1, 0), b3, voffB); PG8_STAGE(PG8_SB(1, 1), b3 + hstep, voffB); PG8_STAGE(PG8_SA(1, 0), a3, voffA);
            PG8_WAIT_V(8); PG8_WAIT_L(0); PG8_BAR; PG8_MMA(1, 0, At, B0); PG8_MMA(1, 1, At, B1); PG8_BAR; PG8_SCHED;
            } else {
            PG8_LDB(B0, 0, 0); PG8_SCHED; PG8_LDA(At, 0, 0); PG8_STAGE(PG8_SA(1, 1), a1 + hstep, voffA);
            PG8_WAIT_L(8); PG8_BAR; PG8_WAIT_L(0); PG8_MMA(0, 0, At, B0); PG8_BAR; PG8_SCHED;
            PG8_LDB(B1, 0, 1); PG8_STAGE(PG8_SB(0, 0), b2, voffB);
            PG8_BAR; PG8_WAIT_L(0); PG8_MMA(0, 1, At, B1); PG8_BAR;
            PG8_LDA(At, 0, 1); PG8_STAGE(PG8_SA(0, 0), a2, voffA);
            PG8_BAR; PG8_WAIT_L(0); PG8_MMA(1, 0, At, B0); PG8_BAR; PG8_SCHED;
            PG8_STAGE(PG8_SB(0, 1), b2 + hstep, voffB);
            PG8_WAIT_V(6); PG8_BAR; PG8_MMA(1, 1, At, B1); PG8_BAR;
            PG8_LDB(B0, 1, 0); PG8_SCHED; PG8_LDA(At, 1, 0); PG8_STAGE(PG8_SA(0, 1), a2 + hstep, voffA);
            PG8_WAIT_L(8); PG8_BAR; PG8_WAIT_L(0); PG8_MMA(0, 0, At, B0); PG8_BAR; PG8_SCHED;
            PG8_LDB(B1, 1, 1); PG8_STAGE(PG8_SB(1, 0), b3, voffB);
            PG8_BAR; PG8_WAIT_L(0); PG8_MMA(0, 1, At, B1); PG8_BAR;
            PG8_LDA(At, 1, 1); PG8_STAGE(PG8_SA(1, 0), a3, voffA);
            PG8_BAR; PG8_WAIT_L(0); PG8_MMA(1, 0, At, B0); PG8_BAR; PG8_SCHED;
            PG8_STAGE(PG8_SB(1, 1), b3 + hstep, voffB);
            PG8_WAIT_V(6); PG8_BAR; PG8_MMA(1, 1, At, B1); PG8_BAR;
            }
        }
        if constexpr (ALIGN_EPI) { if (wr == 0) PG8_BAR; }
        if constexpr (!Epi::AFTER_DRAIN) { E(acc, cur, wr, wc, fr, fq); S.done(cur); }
        if (!has_next) break;
#pragma unroll
        for (int a = 0; a < 2; ++a)
#pragma unroll
            for (int b = 0; b < 2; ++b)
#pragma unroll
                for (int m = 0; m < 4; ++m)
#pragma unroll
                    for (int n = 0; n < 2; ++n) acc[a][b][m][n] = (f32x4){0.f, 0.f, 0.f, 0.f};
        cur = nxt; cA = nA; cB = nB; ++ui;
        if constexpr (ALIGN_EPI) { if (wr == 1) PG8_BAR; }
    }
    PG8_WAIT_V(0);
    if constexpr (!ALIGN_EPI) { if (wr == 0) PG8_BAR; }
    PG8_BAR;
    if constexpr (Epi::AFTER_DRAIN) { E.fused(acc, cur, wr, wc, fr, fq, lds, wid, lane); S.done(cur); }
#undef PG8_SA
#undef PG8_SB
#undef PG8_STAGE
#undef PG8_LDA
#undef PG8_LDB
#undef PG8_MMA
#undef PG8_WAIT_V
#undef PG8_WAIT_L
#undef PG8_BAR
#undef PG8_SCHED
}
}
#define GAS __attribute__((address_space(1)))
#define LAS __attribute__((address_space(3)))
typedef unsigned short bf16;
typedef unsigned v4u __attribute__((ext_vector_type(4)));
typedef float f32x4 __attribute__((ext_vector_type(4)));
typedef short bf16x8 __attribute__((ext_vector_type(8)));
typedef GAS unsigned gu32;
typedef GAS unsigned long long gu64;
#define RLX_AGENT __ATOMIC_RELAXED, __HIP_MEMORY_SCOPE_AGENT
#define LDS_WAIT() asm volatile("s_waitcnt lgkmcnt(0)" ::: "memory")
#define VM_WAIT() asm volatile("s_waitcnt vmcnt(0)" ::: "memory")
__device__ __forceinline__ unsigned long long rt() { return __builtin_amdgcn_s_memrealtime(); }
__device__ __forceinline__ unsigned f2bf(float f) { unsigned u = __builtin_bit_cast(unsigned, f); return (u + 0x7fffu + ((u >> 16) & 1u)) >> 16; }
__device__ __forceinline__ unsigned pk2(float lo, float hi) { return f2bf(lo) | (f2bf(hi) << 16); }
#define XB_TMO      128
#define XB_XCNT(j)  (256  + 64 * (j))
#define XB_XSUB(j)  (1280 + 64 * (j))
#define XB_XGEN(j)  (2304 + 64 * (j))
#define XB_TOP      3328
#define XB_TOPGEN   3392
#define XCD_BAR_WORDS 3456
#define XB_SPIN_CAP (1u << 18)

__device__ __forceinline__ unsigned xb_ld(unsigned* p)              { return __hip_atomic_load(p, __ATOMIC_RELAXED, __HIP_MEMORY_SCOPE_AGENT); }
__device__ __forceinline__ unsigned xb_add(unsigned* p, unsigned v) { return __hip_atomic_fetch_add(p, v, __ATOMIC_RELAXED, __HIP_MEMORY_SCOPE_AGENT); }
__device__ __forceinline__ unsigned xb_xcc_id() { return (unsigned)__builtin_amdgcn_s_getreg((3 << 11) | 20) & 0xFu; }
#define XB_SPIN(cond, bar) do { unsigned _sp = 0; while (cond) { __builtin_amdgcn_s_sleep(1); \
    if ((++_sp & 255u) == 0u) { if (xb_ld(&(bar)[XB_TMO])) break; if (_sp > XB_SPIN_CAP) { atomicAdd(&(bar)[XB_TMO], 1u); break; } } } } while (0)

struct XcdBarrier {
    unsigned* bar; unsigned x;
    volatile LAS unsigned* st;
};

__device__ __forceinline__ XcdBarrier xcd_barrier_post(unsigned* bar, volatile LAS unsigned* st) {
    XcdBarrier b; b.bar = bar; b.x = xb_xcc_id(); b.st = st;
    if (threadIdx.x == 0) (void)xb_add(&bar[XB_XCNT(b.x)], 1u);
    return b;
}
__device__ __forceinline__ void xcd_barrier_complete(unsigned* bar, unsigned x, unsigned& nloc, unsigned& nx) {
    const unsigned G = gridDim.x * gridDim.y * gridDim.z;
    unsigned sum, cnt, mine, sp = 0u;
    for (;;) {
        sum = 0u; cnt = 0u; mine = 0u;
#pragma unroll
        for (unsigned j = 0; j < 16; ++j) { const unsigned c = xb_ld(&bar[XB_XCNT(j)]); sum += c; cnt += (c > 0u) ? 1u : 0u; mine = (j == x) ? c : mine; }
        if (sum == G) break;
        __builtin_amdgcn_s_sleep(1);
        if ((++sp & 255u) == 0u) { if (xb_ld(&bar[XB_TMO])) break; if (sp > XB_SPIN_CAP) { atomicAdd(&bar[XB_TMO], 1u); break; } }
    }
    nloc = mine > 0u ? mine : 1u; nx = cnt > 0u ? cnt : 1u;
}

__device__ __forceinline__ void xcd_barrier(const XcdBarrier& b) {
    asm volatile("s_waitcnt vmcnt(0)" ::: "memory");
    __syncthreads();
    if (threadIdx.x == 0) {
        unsigned* bar = b.bar;
        __builtin_amdgcn_s_waitcnt(0);
        unsigned nloc = b.st[0], nx = b.st[1];
        if (nloc == 0u) { xcd_barrier_complete(bar, b.x, nloc, nx); b.st[0] = nloc; b.st[1] = nx; }
        const unsigned old = xb_add(&bar[XB_XSUB(b.x)], 1u);
        const unsigned gen = old / nloc;
        if (old + 1u == (gen + 1u) * nloc) {
            __builtin_amdgcn_fence(__ATOMIC_RELEASE, "agent");
            asm volatile("s_waitcnt vmcnt(0)" ::: "memory");
            const unsigned og = xb_add(&bar[XB_TOP], 1u);
            const unsigned tg = og / nx;
            if (og + 1u == (tg + 1u) * nx) xb_add(&bar[XB_TOPGEN], 1u);
            else XB_SPIN(xb_ld(&bar[XB_TOPGEN]) == tg, bar);
            __builtin_amdgcn_fence(__ATOMIC_ACQUIRE, "agent");
            xb_add(&bar[XB_XGEN(b.x)], 1u);
            asm volatile("s_waitcnt vmcnt(0)" ::: "memory");
        } else {
            XB_SPIN(xb_ld(&bar[XB_XGEN(b.x)]) == gen, bar);
            __builtin_amdgcn_fence(__ATOMIC_ACQUIRE, "agent");
            asm volatile("s_waitcnt vmcnt(0)" ::: "memory");
        }
    }
    __syncthreads();
}
namespace att {
typedef short bf16x8 __attribute__((ext_vector_type(8)));
typedef short s16x4 __attribute__((ext_vector_type(4)));
typedef float f32x16 __attribute__((ext_vector_type(16)));
typedef float f32x4 __attribute__((ext_vector_type(4)));
typedef unsigned u32x4 __attribute__((ext_vector_type(4)));
typedef unsigned short bf16;
#define ALAS __attribute__((address_space(3)))
typedef ALAS unsigned char* lptr;
constexpr int G_BYTES = 40960, KT_OFF = 0, VT_OFF = 24576;
constexpr int SCR_OFF = 81920;
constexpr int OM_OFF = 0, ML_OFF = 65536;
constexpr int ATT_LDS_BYTES = SCR_OFF + 8 * 512;
#define ASBAR() __builtin_amdgcn_sched_barrier(0)

__device__ __forceinline__ int v_st(int k, int c) { const int kk = (k & ~0xC) | ((k & 4) << 1) | ((k & 8) >> 1); return ((kk >> 3) * 4 + (c >> 5)) * 512 + ((kk & 7) * 32 + (c & 31)) * 2; }
__device__ __forceinline__ int v_rd_base(int lane) { return ((lane & 3) << 3) | (((lane >> 2) & 3) << 6) | (((lane >> 4) & 1) << 5) | (((lane >> 5) & 1) << 8); }
constexpr int v_rd_off(int d0, int ks, int half) { return d0 * 512 + ks * 4096 + half * 2048; }
__device__ __forceinline__ int crow(int r, int hi) { return (r & 3) + 8 * (r >> 2) + 4 * hi; }
__device__ __forceinline__ unsigned cvtpk(float lo, float hi) { unsigned r; asm volatile("v_cvt_pk_bf16_f32 %0, %1, %2" : "=v"(r) : "v"(lo), "v"(hi)); return r; }

__device__ __forceinline__ void mask_tile(f32x16& p0, f32x16& p1, int dq, unsigned W) {
    const float NEG = -__builtin_inff();
#pragma unroll
    for (int r = 0; r < 16; ++r) {
        const int c = (r & 3) + 8 * (r >> 2);
        if ((unsigned)(dq - c) >= W) p0[r] = NEG;
        if ((unsigned)(dq - c - 32) >= W) p1[r] = NEG;
    }
}
__device__ __forceinline__ void partialSM(f32x16& p0, f32x16& p1, float& m_reg, float& mn, float& alpha, const float C2, const float THRR) {
    float pmax = p0[0];
#pragma unroll
    for (int r = 1; r < 16; ++r) pmax = fmaxf(pmax, p0[r]);
#pragma unroll
    for (int r = 0; r < 16; ++r) pmax = fmaxf(pmax, p1[r]);
    { auto rr = __builtin_amdgcn_permlane32_swap(__float_as_uint(pmax), __float_as_uint(pmax), false, false);
      pmax = fmaxf(__uint_as_float(rr[0]), __uint_as_float(rr[1])); }
    if (__builtin_expect(__all((pmax - m_reg) <= THRR), 1)) { mn = m_reg; alpha = 1.f; }
    else { mn = fmaxf(m_reg, pmax); alpha = __builtin_amdgcn_exp2f((m_reg - mn) * C2); m_reg = mn; }
    const float mnL = -mn * C2;
#pragma unroll
    for (int r = 0; r < 16; ++r) p0[r] = fmaf(p0[r], C2, mnL);
#pragma unroll
    for (int r = 0; r < 16; ++r) p1[r] = fmaf(p1[r], C2, mnL);
#pragma unroll
    for (int r = 0; r < 16; ++r) p0[r] = __builtin_amdgcn_exp2f(p0[r]);
}
__device__ __forceinline__ void finishSM(f32x16& p0, f32x16& p1, float alpha, float& l_reg, bf16x8& pa0, bf16x8& pa1, bf16x8& pa2, bf16x8& pa3) {
#pragma unroll
    for (int r = 0; r < 16; ++r) p1[r] = __builtin_amdgcn_exp2f(p1[r]);
    float ps = 0;
#pragma unroll
    for (int r = 0; r < 16; ++r) ps += p0[r];
#pragma unroll
    for (int r = 0; r < 16; ++r) ps += p1[r];
    { auto rr = __builtin_amdgcn_permlane32_swap(__float_as_uint(ps), __float_as_uint(ps), false, false);
      ps = __uint_as_float(rr[0]) + __uint_as_float(rr[1]); }
    l_reg = l_reg * alpha + ps;
#define ATT_PK4(P, B_, OUT) do { unsigned a0 = cvtpk(P[B_+0], P[B_+1]), a1 = cvtpk(P[B_+2], P[B_+3]);                          \
        unsigned b0 = cvtpk(P[B_+4], P[B_+5]), b1 = cvtpk(P[B_+6], P[B_+7]);                                             \
        auto r0 = __builtin_amdgcn_permlane32_swap(a0, b0, false, false); auto r1 = __builtin_amdgcn_permlane32_swap(a1, b1, false, false); \
        u32x4 w = {r0[0], r1[0], r0[1], r1[1]}; OUT = __builtin_bit_cast(bf16x8, w); } while (0)
    ATT_PK4(p0, 0, pa0); ATT_PK4(p0, 8, pa1); ATT_PK4(p1, 0, pa2); ATT_PK4(p1, 8, pa3);
#undef ATT_PK4
}
template <int KSTR> __device__ __forceinline__ int kswz(int row) { return KSTR == 384 ? ((row >> 1) & 7) : (row & 7); }
template <int ND0, int KSTR>
__device__ __forceinline__ void qkt(f32x16& p0, f32x16& p1, lptr Kt, int r32, int hi, const bf16x8* qr) {
#pragma unroll
    for (int r = 0; r < 16; ++r) { p0[r] = 0.f; p1[r] = 0.f; }
    const int sw = kswz<KSTR>(r32) << 4;
    lptr kb[4];
#pragma unroll
    for (int dd = 0; dd < 4; ++dd) kb[dd] = Kt + r32 * KSTR + ((dd * 32 + hi * 16) ^ sw);
#pragma unroll
    for (int d0 = 0; d0 < ND0; ++d0) { lptr a = kb[d0 & 3] + (d0 >> 2) * 128;
        const bf16x8 b0 = *(const ALAS bf16x8*)a;
        const bf16x8 b1 = *(const ALAS bf16x8*)(a + 32 * KSTR);
        p0 = __builtin_amdgcn_mfma_f32_32x32x16_bf16(b0, qr[d0], p0, 0, 0, 0);
        p1 = __builtin_amdgcn_mfma_f32_32x32x16_bf16(b1, qr[d0], p1, 0, 0, 0); }
}
__device__ __forceinline__ void pv_tile(f32x16* o, unsigned vb0, bf16x8 pa0, bf16x8 pa1, bf16x8 pa2, bf16x8 pa3) {
#define ATT_TRRD(dst, off) asm volatile("ds_read_b64_tr_b16 %0, %1 offset:%2" : "=&v"(dst) : "v"(vb0), "i"(off) : "memory")
#define ATT_PV_D0(d0) do { s16x4 l0, l1, l2, l3, h0, h1, h2, h3; constexpr int b_ = v_rd_off(d0, 0, 0); \
        ATT_TRRD(l0, b_); ATT_TRRD(h0, b_ + 2048); ATT_TRRD(l1, b_ + 4096); ATT_TRRD(h1, b_ + 6144); ATT_TRRD(l2, b_ + 8192); ATT_TRRD(h2, b_ + 10240); ATT_TRRD(l3, b_ + 12288); ATT_TRRD(h3, b_ + 14336); \
        asm volatile("s_waitcnt lgkmcnt(0)" ::: "memory"); ASBAR(); \
        o[d0] = __builtin_amdgcn_mfma_f32_32x32x16_bf16(pa0, (bf16x8){l0[0], l0[1], l0[2], l0[3], h0[0], h0[1], h0[2], h0[3]}, o[d0], 0, 0, 0);   \
        o[d0] = __builtin_amdgcn_mfma_f32_32x32x16_bf16(pa1, (bf16x8){l1[0], l1[1], l1[2], l1[3], h1[0], h1[1], h1[2], h1[3]}, o[d0], 0, 0, 0);   \
        o[d0] = __builtin_amdgcn_mfma_f32_32x32x16_bf16(pa2, (bf16x8){l2[0], l2[1], l2[2], l2[3], h2[0], h2[1], h2[2], h2[3]}, o[d0], 0, 0, 0);   \
        o[d0] = __builtin_amdgcn_mfma_f32_32x32x16_bf16(pa3, (bf16x8){l3[0], l3[1], l3[2], l3[3], h3[0], h3[1], h3[2], h3[3]}, o[d0], 0, 0, 0); } while (0)
    ATT_PV_D0(0); ATT_PV_D0(1); ATT_PV_D0(2); ATT_PV_D0(3);
#undef ATT_PV_D0
#undef ATT_TRRD
}

struct UnitIO { const bf16* Q; size_t q_rs; const bf16* K; size_t k_rs; const bf16* KR; const bf16* V; size_t v_rs; bf16* O; size_t o_rs;
                float* lse; size_t lse_rs; const bf16* O2; const bf16* O3; const float* lse2; const float* lse3; int nsteps, q0, kbase0, g0_active; };
template <int MODE>
__device__ __forceinline__ void attn_unit(lptr lds, const UnitIO& U) {
    constexpr int DQK = MODE == 0 ? 192 : 128, ND0 = DQK / 16, KSTR = DQK * 2;
    constexpr float SCALE = MODE == 0 ? 0.0721687836487032f : 0.0883883476483184f, C2 = 1.4426950408889634f * SCALE, THRR = 8.0f / SCALE;
    int tid_ = threadIdx.x; asm volatile("" : "+v"(tid_));
    const int tid = tid_, wid = __builtin_amdgcn_readfirstlane(tid >> 6), lane = tid & 63, r32 = lane & 31, hi = lane >> 5;
    const int g = wid >> 2, wq = wid & 3, tg = tid & 255;
    lptr Kt = lds + g * G_BYTES + KT_OFF; lptr Vt = lds + g * G_BYTES + VT_OFF;
    ALAS float* scr = (ALAS float*)(lds + SCR_OFF + wid * 512);
    const unsigned vb0 = (unsigned)(size_t)Vt + (unsigned)v_rd_base(lane);
    const bool act = (MODE == 0) || g == 1 || U.g0_active != 0;
    bf16x8 qr[ND0];
    { const bf16* qrow = U.Q + (size_t)(wq * 32 + r32) * U.q_rs + hi * 8;
#pragma unroll
      for (int d0 = 0; d0 < ND0; ++d0) qr[d0] = *(const bf16x8*)(qrow + d0 * 16); }
    const int srow = tg >> 4, sch = tg & 15, rrow = tg >> 3, rch = tg & 7;
    bf16x8 stK[4], stV[4], stR[2];
#define ATT_TILE(s) (MODE == 0 ? 2 * (s) + g : 2 * g + (s))
#define ATT_ISSUE(t) do { const long kb_ = (long)U.kbase0 + 64 * (t); \
        _Pragma("unroll") for (int i_ = 0; i_ < 4; ++i_) stK[i_] = *(const bf16x8*)(U.K + (size_t)(kb_ + srow + 16 * i_) * U.k_rs + sch * 8); \
        _Pragma("unroll") for (int i_ = 0; i_ < 4; ++i_) stV[i_] = *(const bf16x8*)(U.V + (size_t)(kb_ + srow + 16 * i_) * U.v_rs + sch * 8); \
        if (MODE == 0) { _Pragma("unroll") for (int i_ = 0; i_ < 2; ++i_) stR[i_] = *(const bf16x8*)(U.KR + (size_t)(kb_ + rrow + 32 * i_) * 64 + rch * 8); } } while (0)
#define ATT_WRITE() do { \
        _Pragma("unroll") for (int i_ = 0; i_ < 4; ++i_) { const int row_ = srow + 16 * i_; \
            *(ALAS bf16x8*)(Kt + row_ * KSTR + ((sch * 16) ^ (kswz<KSTR>(row_) << 4))) = stK[i_]; *(ALAS bf16x8*)(Vt + v_st(row_, sch * 8)) = stV[i_]; } \
        if (MODE == 0) { _Pragma("unroll") for (int i_ = 0; i_ < 2; ++i_) { const int row_ = rrow + 32 * i_; \
            *(ALAS bf16x8*)(Kt + row_ * KSTR + 256 + ((rch * 16) ^ (kswz<KSTR>(row_) << 4))) = stR[i_]; } } } while (0)
    float m_reg = -1e30f, l_reg = 0.f; f32x16 o[4];
#pragma unroll
    for (int d = 0; d < 4; ++d)
#pragma unroll
        for (int r = 0; r < 16; ++r) o[d][r] = 0.f;
    if (act) { ATT_ISSUE(ATT_TILE(0)); ASBAR(); ATT_WRITE(); }
    __syncthreads();
    const int qlo = U.q0 + wq * 32;
    const unsigned W = MODE == 0 ? 0x7fffffffu : 129u;
    for (int s = 0; s < U.nsteps; ++s) {
        const bool more = s + 1 < U.nsteps;
        if (more && act) ATT_ISSUE(ATT_TILE(s + 1));
        ASBAR();
        if (act) {
            const int kb = U.kbase0 + 64 * ATT_TILE(s);
            f32x16 p0, p1; qkt<ND0, KSTR>(p0, p1, Kt, r32, hi, qr);
            if (MODE != 0 || kb + 63 > qlo) mask_tile(p0, p1, qlo + r32 - 4 * hi - kb, W);
            float mn, alpha; partialSM(p0, p1, m_reg, mn, alpha, C2, THRR);
            bf16x8 pa0, pa1, pa2, pa3; finishSM(p0, p1, alpha, l_reg, pa0, pa1, pa2, pa3);
            if (__any(alpha < 1.f)) { if (hi == 0) scr[r32] = alpha; asm volatile("s_waitcnt lgkmcnt(0)" ::: "memory");
#pragma unroll
                for (int d = 0; d < 4; ++d)
#pragma unroll
                    for (int r = 0; r < 16; ++r) o[d][r] *= scr[crow(r, hi)]; }
            ASBAR();
            pv_tile(o, vb0, pa0, pa1, pa2, pa3);
        }
        __syncthreads();
        if (more && act) ATT_WRITE();
        __syncthreads();
    }
    ALAS float* OM = (ALAS float*)(lds + OM_OFF) + wq * 4096;
    ALAS float* ML = (ALAS float*)(lds + ML_OFF) + wq * 64;
    if (g == 1) {
#pragma unroll
        for (int d = 0; d < 4; ++d)
#pragma unroll
            for (int r = 0; r < 16; ++r) OM[crow(r, hi) * 128 + d * 32 + r32] = o[d][r];
        if (hi == 0) { ML[r32 * 2] = m_reg; ML[r32 * 2 + 1] = l_reg; }
    }
    __syncthreads();
    if (g == 0) {
        const float m1 = ML[r32 * 2], l1 = ML[r32 * 2 + 1];
        const float m = fmaxf(m_reg, m1), f0 = __builtin_amdgcn_exp2f((m_reg - m) * C2), f1 = __builtin_amdgcn_exp2f((m1 - m) * C2);
        const float L = l_reg * f0 + l1 * f1, inv = 1.0f / L;
        float ca = f0 * inv, cb = f1 * inv, c2 = 0.f, c3 = 0.f;
        if (MODE != 0) {
            const float lse1 = m * SCALE + logf(L);
            if (MODE == 1) { if (hi == 0) U.lse[(size_t)(wq * 32 + r32) * U.lse_rs] = lse1; }
            else { const float e2 = U.lse2[(size_t)(wq * 32 + r32) * U.lse_rs], e3 = U.lse3[(size_t)(wq * 32 + r32) * U.lse_rs];
                   const float mx = fmaxf(lse1, fmaxf(e2, e3)), w1 = expf(lse1 - mx), w2 = expf(e2 - mx), w3 = expf(e3 - mx), iz = 1.0f / (w1 + w2 + w3);
                   ca *= w1 * iz; cb *= w1 * iz; c2 = w2 * iz; c3 = w3 * iz; }
        }
        if (hi == 0) { scr[r32 * 4] = ca; scr[r32 * 4 + 1] = cb; scr[r32 * 4 + 2] = c2; scr[r32 * 4 + 3] = c3; }
        asm volatile("s_waitcnt lgkmcnt(0)" ::: "memory");
#pragma unroll
        for (int r = 0; r < 16; ++r) { const int row = crow(r, hi); const f32x4 cf = *(const ALAS f32x4*)(scr + row * 4);
            const size_t j = (size_t)(wq * 32 + row);
#pragma unroll
            for (int d = 0; d < 4; ++d) { float v = o[d][r] * cf[0] + OM[row * 128 + d * 32 + r32] * cf[1];
                if (MODE == 2) { const unsigned a2 = U.O2[j * U.q_rs + d * 32 + r32], a3 = U.O3[j * U.q_rs + d * 32 + r32];
                    v += cf[2] * __uint_as_float(a2 << 16) + cf[3] * __uint_as_float(a3 << 16); }
                const float vn = __shfl_xor(v, 1);
                if ((r32 & 1) == 0) *(unsigned*)(U.O + j * U.o_rs + d * 32 + r32) = cvtpk(v, vn); } }
    }
    __syncthreads();
#undef ATT_TILE
#undef ATT_ISSUE
#undef ATT_WRITE
}
}

static_assert(att::ATT_LDS_BYTES <= RING_BYTES, "attention scratch inside the ring region");
struct Frame { LAS unsigned char* lds; int G; };
struct Lane { int tid, lane, wave; };
__device__ __forceinline__ Lane get_lane() { int t = threadIdx.x; asm volatile("" : "+v"(t)); Lane L; L.tid = t; L.lane = t & 63; L.wave = __builtin_amdgcn_readfirstlane(t >> 6); return L; }
__device__ __forceinline__ float wave_sum(float v) {
#pragma unroll
    for (int o = 1; o < 64; o <<= 1) v += __shfl_xor(v, o);
    return v;
}
template <class MAP>
__device__ __forceinline__ void transpose_item(const float* W, int K, int N, const float* kscale, bf16* WT, const MAP& map, LAS float* scr, int item, int lane) {
    const int nblk = N / 32, kb = item / nblk, nb = item % nblk, k0 = 64 * kb, n0 = 32 * nb;
#pragma unroll 8
    for (int i = 0; i < 32; ++i) { const int kk = 2 * i + (lane >> 5); float v = W[(size_t)(k0 + kk) * N + n0 + (lane & 31)]; if (kscale) v *= kscale[k0 + kk]; scr[kk * 33 + (lane & 31)] = v; }
    LDS_WAIT(); asm volatile("" ::: "memory");
    const int c = lane & 7;
#pragma unroll
    for (int j = 0; j < 4; ++j) { const int n = (lane >> 3) + 8 * j; const LAS float* s = scr + (8 * c) * 33 + n;
        v4u o; o.x = pk2(s[0 * 33], s[1 * 33]); o.y = pk2(s[2 * 33], s[3 * 33]); o.z = pk2(s[4 * 33], s[5 * 33]); o.w = pk2(s[6 * 33], s[7 * 33]);
        *(GAS v4u*)(WT + (size_t)map(n0 + n) * K + k0 + 8 * c) = o; }
    LDS_WAIT(); asm volatile("" ::: "memory");
}
struct MapId { __device__ __forceinline__ int operator()(int j) const { return j; } };
struct MapGU { int up; __device__ __forceinline__ int operator()(int j) const { return (j >> 7) * 256 + up * 128 + (j & 127); } };
struct MapWin { __device__ __forceinline__ int operator()(int j) const {
    if (j < 1024) return j;
    if (j < 1088) { const int jj = j - 1024; return 16 * 256 + (jj >> 5) * 128 + (jj & 31); }
    if (j < 3136) { const int jj = j - 1088, which = jj >> 10, hh = (jj & 1023) >> 7, dim = jj & 127, t = hh >> 1, isB = hh & 1, tb = (4 + which * 4 + t) * 256;
        if (dim < 16) return tb + dim + 16 * isB;
        if (dim < 32) return tb + 128 + (dim - 16) + 16 * isB;
        return tb + isB * 128 + dim; }
    return 12 * 256 + (j - 3136); } };
struct MapUq { __device__ __forceinline__ int operator()(int j) const { const int head = j / 192, d = j - head * 192;
    if (d < 128) return (head >> 1) * 256 + (head & 1) * 128 + d;
    const int x2 = d >= 160, f = d - 128 - 32 * x2; return (4 + (head >> 2)) * 256 + x2 * 128 + 32 * (head & 3) + f; } };

__device__ __forceinline__ void sincos_d(double a, float& sn, float& cs) {
    const double TWO_PI = 6.283185307179586476925286766559, INV_2PI = 0.15915494309189533576888376337251;
    const double k = __builtin_rint(a * INV_2PI); const double r = __builtin_fma(-k, TWO_PI, a); const double z = r * r;
    double s = 1.13099628864477159e-31, c = -3.76998762881590539e-33;
#define HS(x) s = __builtin_fma(s, z, x)
#define HC(x) c = __builtin_fma(c, z, x)
    HS(-9.18368986379554601e-29); HS(6.44695028438447359e-26); HS(-3.86817017063068413e-23); HS(1.95729410633912626e-20); HS(-8.22063524662432950e-18); HS(2.81145725434552060e-15); HS(-7.64716373181981641e-13);
    HS(1.60590438368216133e-10); HS(-2.50521083854417202e-08); HS(2.75573192239858925e-06); HS(-1.98412698412698413e-04); HS(8.33333333333333322e-03); HS(-1.66666666666666657e-01); HS(1.0);
    HC(3.27988923706983776e-30); HC(-2.47959626322479759e-27); HC(1.61173757109611839e-24); HC(-8.89679139245057408e-22); HC(4.11031762331216484e-19); HC(-1.56192069685862253e-16); HC(4.77947733238738525e-14);
    HC(-1.14707455977297245e-11); HC(2.08767569878681002e-09); HC(-2.75573192239858883e-07); HC(2.48015873015873016e-05); HC(-1.38888888888888894e-03); HC(4.16666666666666644e-02); HC(-5.0e-01); HC(1.0);
#undef HS
#undef HC
    sn = (float)(s * r); cs = (float)c;
}
__device__ __forceinline__ void row_pass(const Frame& Fr, const float* xin, const float* Y, float coef, const float* gpost, const float* gpre, float* X, bf16* H) {
    const Lane F = get_lane();
    const int gw = blockIdx.x * NWAVES + F.wave, NGW = Fr.G * NWAVES;
    for (int row = gw; row < S; row += NGW) {
        const GAS f32x4* xr = (const GAS f32x4*)(xin + (size_t)row * DM) + F.lane;
        f32x4 x[8];
#pragma unroll
        for (int j = 0; j < 8; ++j) x[j] = xr[64 * j];
        if (Y) {
            const GAS f32x4* yr = (const GAS f32x4*)(Y + (size_t)row * DM) + F.lane; f32x4 y[8]; float s = 0.f;
#pragma unroll
            for (int j = 0; j < 8; ++j) { y[j] = yr[64 * j]; s += (y[j][0] * y[j][0] + y[j][1] * y[j][1]) + (y[j][2] * y[j][2] + y[j][3] * y[j][3]); }
            const float rs = coef / sqrtf(wave_sum(s) * (1.0f / DM) + 1e-6f);
#pragma unroll
            for (int j = 0; j < 8; ++j) { const f32x4 gp = *((const GAS f32x4*)gpost + F.lane + 64 * j); x[j] = x[j] + y[j] * gp * rs; }
        }
        GAS f32x4* xo = (GAS f32x4*)(X + (size_t)row * DM) + F.lane;
#pragma unroll
        for (int j = 0; j < 8; ++j) xo[64 * j] = x[j];
        if (gpre) {
            float s = 0.f;
#pragma unroll
            for (int j = 0; j < 8; ++j) s += (x[j][0] * x[j][0] + x[j][1] * x[j][1]) + (x[j][2] * x[j][2] + x[j][3] * x[j][3]);
            const float rs = 1.0f / sqrtf(wave_sum(s) * (1.0f / DM) + 1e-6f);
            GAS unsigned long long* ho = (GAS unsigned long long*)(H + (size_t)row * DM) + F.lane;
#pragma unroll
            for (int j = 0; j < 8; ++j) { const f32x4 gp = *((const GAS f32x4*)gpre + F.lane + 64 * j); const f32x4 h = x[j] * gp * rs;
                ho[64 * j] = (unsigned long long)pk2(h[0], h[1]) | ((unsigned long long)pk2(h[2], h[3]) << 32); }
        }
    }
}

struct Args { const float* in[20]; float* out; unsigned char* ws; int ph_lo, ph_hi; };
typedef const __attribute__((address_space(4))) Args* KArgs;
__device__ __forceinline__ KArgs get_args() { KArgs p = (KArgs)__builtin_amdgcn_kernarg_segment_ptr(); asm volatile("" : "+s"(p)); return p; }

__device__ __forceinline__ void phase_prologue(const Frame& Fr) {
    KArgs A = get_args(); unsigned char* ws = A->ws; const Lane F = get_lane();
    LAS float* scr = (LAS float*)(Fr.lds + RING_OFF + F.wave * 16384);
    const int gw = blockIdx.x * NWAVES + F.wave, NGW = Fr.G * NWAVES;
    constexpr int I_FF = (DM / 64) * (DFF / 32), I_IN = (DM / 64) * (NIN / 32), I_UQ = (512 / 64) * (1536 / 32), I_UKV = (512 / 64) * (2048 / 32), I_O = (DM / 64) * (DM / 32), I_Z = 192;
    constexpr int I_LAYER = 6 * I_FF + I_IN + I_UQ + I_UKV + I_O + I_Z;
    for (int it = gw; it < DEPTH * I_LAYER; it += NGW) {
        const int l = it / I_LAYER; int r = it - l * I_LAYER; unsigned char* wl = ws + WS_W + (size_t)l * W_LAYER;
        if (r < I_FF) { transpose_item(A->in[4] + (size_t)l * DM * DFF, DM, DFF, nullptr, (bf16*)(wl + WO_GU1), MapGU{0}, scr, r, F.lane); continue; } r -= I_FF;
        if (r < I_FF) { transpose_item(A->in[5] + (size_t)l * DM * DFF, DM, DFF, nullptr, (bf16*)(wl + WO_GU1), MapGU{1}, scr, r, F.lane); continue; } r -= I_FF;
        if (r < I_FF) { transpose_item(A->in[6] + (size_t)l * DFF * DM, DFF, DM, nullptr, (bf16*)(wl + WO_D1), MapId{}, scr, r, F.lane); continue; } r -= I_FF;
        if (r < I_FF) { transpose_item(A->in[17] + (size_t)l * DM * DFF, DM, DFF, nullptr, (bf16*)(wl + WO_GU2), MapGU{0}, scr, r, F.lane); continue; } r -= I_FF;
        if (r < I_FF) { transpose_item(A->in[18] + (size_t)l * DM * DFF, DM, DFF, nullptr, (bf16*)(wl + WO_GU2), MapGU{1}, scr, r, F.lane); continue; } r -= I_FF;
        if (r < I_FF) { transpose_item(A->in[19] + (size_t)l * DFF * DM, DFF, DM, nullptr, (bf16*)(wl + WO_D2), MapId{}, scr, r, F.lane); continue; } r -= I_FF;
        if (r < I_IN) { transpose_item(A->in[9] + (size_t)l * DM * NIN, DM, NIN, nullptr, (bf16*)(wl + WO_IN), MapWin{}, scr, r, F.lane); continue; } r -= I_IN;
        if (r < I_UQ) { transpose_item(A->in[11] + (size_t)l * 512 * 1536, 512, 1536, A->in[10] + l * 512, (bf16*)(wl + WO_UQ), MapUq{}, scr, r, F.lane); continue; } r -= I_UQ;
        if (r < I_UKV) { transpose_item(A->in[13] + (size_t)l * 512 * 2048, 512, 2048, A->in[12] + l * 512, (bf16*)(wl + WO_UKV), MapId{}, scr, r, F.lane); continue; } r -= I_UKV;
        if (r < I_O) { transpose_item(A->in[14] + (size_t)l * DM * DM, DM, DM, nullptr, (bf16*)(wl + WO_O), MapId{}, scr, r, F.lane); continue; } r -= I_O;
        { const int prow = 16 * 256 + (r / 96) * 128 + 32 + (r % 96);
          GAS v4u* z = (GAS v4u*)((bf16*)(wl + WO_IN) + (size_t)prow * DM) + F.lane;
#pragma unroll
          for (int j = 0; j < 4; ++j) z[64 * j] = (v4u){0u, 0u, 0u, 0u}; }
    }
    const int* pos = (const int*)A->in[1]; float* TA = (float*)(ws + WS_TA); float* TP = (float*)(ws + WS_TP);
    for (int i = blockIdx.x * (NWAVES * 64) + F.tid; i < S * 48; i += Fr.G * NWAVES * 64) {
        const int t = i / 48, f = i - t * 48; const bool part = f >= 32; const int fi = part ? f - 32 : f;
        const double ratio = part ? 4.40366602671780460465e-01 : 6.63601237696088475104e-01; double inv = 1.0;
        for (int k = 0; k < fi; ++k) inv *= ratio;
        float sn, cs; sincos_d((double)pos[t] * inv, sn, cs);
        if (part) { TP[(size_t)t * 32 + fi] = cs; TP[(size_t)t * 32 + 16 + fi] = sn; } else { TA[(size_t)t * 64 + fi] = cs; TA[(size_t)t * 64 + 32 + fi] = sn; }
    }
    row_pass(Fr, A->in[0], nullptr, 0.f, nullptr, A->in[2], A->out, (bf16*)(ws + WS_H));
}
__device__ __forceinline__ void phase_dilated12(const Frame& F) {
    KArgs A = get_args(); unsigned char* ws = A->ws;
    bf16* DQ = (bf16*)(ws + WS_DQ); bf16* DK = (bf16*)(ws + WS_DK); bf16* DV = (bf16*)(ws + WS_DV);
    for (int u = blockIdx.x; u < 1024; u += F.G) {
        const int pat = 1 + (u >> 9), uu = u & 511, h = uu & 7, bi = uu >> 3, d = pat == 1 ? 4 : 16, r = bi % d, n = bi / d;
        const size_t tok0 = (size_t)(128 * n) * d + r;
        att::UnitIO U; U.Q = DQ + tok0 * 1024 + h * 128; U.q_rs = (size_t)d * 1024; U.K = DK + (size_t)r * 1024 + h * 128; U.k_rs = (size_t)d * 1024; U.KR = nullptr;
        U.V = DV + (size_t)r * 1024 + h * 128; U.v_rs = (size_t)d * 1024; U.O = (bf16*)(ws + (pat == 1 ? WS_O2 : WS_O3)) + tok0 * 1024 + h * 128; U.o_rs = (size_t)d * 1024;
        U.lse = (float*)(ws + (pat == 1 ? WS_LSE2 : WS_LSE3)) + tok0 * 8 + h; U.lse_rs = (size_t)d * 8; U.O2 = nullptr; U.O3 = nullptr; U.lse2 = nullptr; U.lse3 = nullptr;
        U.nsteps = 2; U.q0 = 128 * n; U.kbase0 = 128 * (n - 1); U.g0_active = n > 0;
        att::attn_unit<1>(F.lds + RING_OFF, U);
    }
}
__device__ __forceinline__ void phase_mla(const Frame& F) {
    KArgs A = get_args(); unsigned char* ws = A->ws;
    for (int L = blockIdx.x; L < 256; L += F.G) {
        const int h = L & 7, x = L >> 3;
        for (int pass = 0; pass < 2; ++pass) { const int qb = pass ? x : 63 - x;
            att::UnitIO U; U.Q = (bf16*)(ws + WS_QA) + (size_t)(128 * qb) * 1536 + h * 192; U.q_rs = 1536; U.K = (bf16*)(ws + WS_KN) + h * 128; U.k_rs = 1024; U.KR = (bf16*)(ws + WS_KR);
            U.V = (bf16*)(ws + WS_VA) + h * 128; U.v_rs = 1024;
            U.O = (bf16*)(ws + WS_OCAT) + (size_t)(128 * qb) * 2048 + h * 128; U.o_rs = 2048; U.lse = nullptr; U.lse_rs = 0; U.O2 = nullptr; U.O3 = nullptr; U.lse2 = nullptr; U.lse3 = nullptr;
            U.nsteps = qb + 1; U.q0 = 128 * qb; U.kbase0 = 0; U.g0_active = 1;
            att::attn_unit<0>(F.lds + RING_OFF, U); }
    }
}
__device__ __forceinline__ void phase_dilated0(const Frame& F) {
    KArgs A = get_args(); unsigned char* ws = A->ws;
    for (int u = blockIdx.x; u < 512; u += F.G) {
        const int h = u & 7, n = u >> 3; const size_t tok0 = (size_t)128 * n;
        att::UnitIO U; U.Q = (bf16*)(ws + WS_DQ) + tok0 * 1024 + h * 128; U.q_rs = 1024; U.K = (bf16*)(ws + WS_DK) + h * 128; U.k_rs = 1024; U.KR = nullptr; U.V = (bf16*)(ws + WS_DV) + h * 128; U.v_rs = 1024;
        U.O = (bf16*)(ws + WS_OCAT) + tok0 * 2048 + 1024 + h * 128; U.o_rs = 2048; U.lse = nullptr; U.lse_rs = 8; U.O2 = (bf16*)(ws + WS_O2) + tok0 * 1024 + h * 128; U.O3 = (bf16*)(ws + WS_O3) + tok0 * 1024 + h * 128;
        U.lse2 = (float*)(ws + WS_LSE2) + tok0 * 8 + h; U.lse3 = (float*)(ws + WS_LSE3) + tok0 * 8 + h; U.nsteps = 2; U.q0 = 128 * n; U.kbase0 = 128 * (n - 1); U.g0_active = n > 0;
        att::attn_unit<2>(F.lds + RING_OFF, U);
    }
}

__global__ void __launch_bounds__(NWAVES * 64, 2) mk_fwd(Args args) {
    extern __shared__ __attribute__((aligned(16))) unsigned char lds_raw[];
    Frame F; F.lds = (LAS unsigned char*)lds_raw; F.G = gridDim.x;
    volatile LAS unsigned* MISC = (volatile LAS unsigned*)(F.lds + MISC_OFF);
    for (int u = threadIdx.x; u < (LDS_BYTES - LDSCTL_OFF) / 4; u += NWAVES * 64) ((LAS unsigned*)(F.lds + LDSCTL_OFF))[u] = 0u;
    __syncthreads();
    const int lo = args.ph_lo, hi = args.ph_hi;
    XcdBarrier bar; bar.bar = (unsigned*)(args.ws + WS_CTL) + CW_BAR; bar.x = 0; bar.st = nullptr;
    if (hi - lo > 1) bar = xcd_barrier_post((unsigned*)(args.ws + WS_CTL) + CW_BAR, MISC + 8);
    int ph = 0;
#define IN_PH() (ph >= lo && ph < hi)
#define SEAM() do { if (ph >= lo && ph + 1 < hi) xcd_barrier(bar); ++ph; } while (0)

    if (IN_PH()) phase_prologue(F);
    SEAM();

    for (int l = 0; l < DEPTH; ++l) {
        for (int s3 = 0; s3 < 3; ++s3) {
            if (s3 != 1) {
                const int f2 = s3 >> 1;
                if (IN_PH()) { KArgs A = get_args(); unsigned char* ws = A->ws; unsigned char* wl = ws + WS_W + (size_t)l * W_LAYER;
                    pg8::Gemm g{(const bf16*)(ws + WS_H), (const bf16*)(wl + (f2 ? WO_GU2 : WO_GU1)), S, 2 * DFF, DM}; pg8::StaticOrder SO; SO.init(S, 2 * DFF, F.G, (int)blockIdx.x); pg8::EpiSwiGLU E{(bf16*)(ws + WS_ACT), DFF};
                    pg8::gemm_phase<pg8::EpiSwiGLU, pg8::StaticOrder, true, true>(F.lds + RING_OFF, g, SO, E); }
                SEAM();
                if (IN_PH()) { KArgs A = get_args(); unsigned char* ws = A->ws; unsigned char* wl = ws + WS_W + (size_t)l * W_LAYER;
                    pg8::Gemm g{(const bf16*)(ws + WS_ACT), (const bf16*)(wl + (f2 ? WO_D2 : WO_D1)), S, DM, DFF}; pg8::StaticOrder SO; SO.init(S, DM, F.G, (int)blockIdx.x); pg8::EpiF32 E{(float*)(ws + WS_Y), DM};
                    pg8::gemm_phase<pg8::EpiF32, pg8::StaticOrder, true, true>(F.lds + RING_OFF, g, SO, E); }
                SEAM();
                if (IN_PH()) { KArgs A = get_args(); unsigned char* ws = A->ws;
                    const float* gpost = A->in[f2 ? 16 : 3] + l * DM; const float* gpre = f2 ? (l + 1 < DEPTH ? A->in[2] + (l + 1) * DM : nullptr) : A->in[7] + l * DM;
                    row_pass(F, A->out, (const float*)(ws + WS_Y), 0.5f, gpost, gpre, A->out, (bf16*)(ws + WS_H)); }
                SEAM();
            } else {
                if (IN_PH()) { KArgs A = get_args(); unsigned char* ws = A->ws; unsigned char* wl = ws + WS_W + (size_t)l * W_LAYER;
                    pg8::Gemm g{(const bf16*)(ws + WS_H), (const bf16*)(wl + WO_IN), S, NIN_PHYS, DM}; pg8::StaticOrder SO; SO.init(S, NIN_PHYS, F.G, (int)blockIdx.x); pg8::EpiWin E{ws};
                    pg8::gemm_phase<pg8::EpiWin, pg8::StaticOrder, true, true>(F.lds + RING_OFF, g, SO, E); }
                SEAM();
                if (IN_PH()) {
                    { KArgs A = get_args(); unsigned char* ws = A->ws; unsigned char* wl = ws + WS_W + (size_t)l * W_LAYER;
                      pg8::Gemm g{(const bf16*)(ws + WS_CQ), (const bf16*)(wl + WO_UQ), S, 1536, 512}; pg8::StaticOrder SO; SO.init(S, 1536, F.G, (int)blockIdx.x); pg8::EpiUq E{ws};
                      pg8::gemm_phase<pg8::EpiUq, pg8::StaticOrder, true, true>(F.lds + RING_OFF, g, SO, E); }
                    { KArgs A = get_args(); unsigned char* ws = A->ws; unsigned char* wl = ws + WS_W + (size_t)l * W_LAYER;
                      pg8::Gemm g{(const bf16*)(ws + WS_CKV), (const bf16*)(wl + WO_UKV), S, 2048, 512}; pg8::StaticOrder SO; SO.init(S, 2048, F.G, (int)((blockIdx.x + 64u) % (unsigned)F.G)); pg8::EpiUkv E{ws};
                      pg8::gemm_phase<pg8::EpiUkv, pg8::StaticOrder, true, true>(F.lds + RING_OFF, g, SO, E); }
                    phase_dilated12(F);
                }
                SEAM();
                if (IN_PH()) { phase_mla(F); phase_dilated0(F); }
                SEAM();
                if (IN_PH()) { KArgs A = get_args(); unsigned char* ws = A->ws; unsigned char* wl = ws + WS_W + (size_t)l * W_LAYER;
                    pg8::Gemm g{(const bf16*)(ws + WS_OCAT), (const bf16*)(wl + WO_O), S, DM, DM}; pg8::StaticOrder SO; SO.init(S, DM, F.G, (int)blockIdx.x); pg8::EpiF32 E{(float*)(ws + WS_Y), DM};
                    pg8::gemm_phase<pg8::EpiF32, pg8::StaticOrder, true, true>(F.lds + RING_OFF, g, SO, E); }
                SEAM();
                if (IN_PH()) { KArgs A = get_args(); unsigned char* ws = A->ws; row_pass(F, A->out, (const float*)(ws + WS_Y), 1.0f, A->in[8] + l * DM, A->in[15] + l * DM, A->out, (bf16*)(ws + WS_H)); }
                SEAM();
            }
        }
    }
#undef IN_PH
#undef SEAM
}
extern "C" void kernel_launch(void* const* d_in, const int* in_sizes, int n_in, void* d_out, int out_size, void* d_ws, size_t ws_size, hipStream_t stream) {
    static int grid = 0;
    if (grid == 0) {
        if (n_in != 20 || in_sizes[0] != S * DM || out_size != S * DM || ws_size < WS_END) { fprintf(stderr, "kernel_launch: unexpected shapes (n_in %d, in0 %d, out %d, ws %zu < %zu); nothing launched\n", n_in, n_in > 0 ? in_sizes[0] : -1, out_size, ws_size, (size_t)WS_END); grid = -1; return; }
        int dev = 0, cus = 0, per_cu = 0;
        if (hipGetDevice(&dev) != hipSuccess || hipDeviceGetAttribute(&cus, hipDeviceAttributeMultiprocessorCount, dev) != hipSuccess) { fprintf(stderr, "kernel_launch: device query failed\n"); grid = -1; return; }
        if (hipFuncSetAttribute((const void*)mk_fwd, hipFuncAttributeMaxDynamicSharedMemorySize, LDS_BYTES) != hipSuccess) { fprintf(stderr, "kernel_launch: hipFuncSetAttribute failed\n"); grid = -1; return; }
        if (hipOccupancyMaxActiveBlocksPerMultiprocessor(&per_cu, (const void*)mk_fwd, NWAVES * 64, LDS_BYTES) != hipSuccess || per_cu < 1) { fprintf(stderr, "kernel_launch: occupancy query reports %d workgroups per CU\n", per_cu); }
        (void)hipGetLastError();
        grid = cus;
    }
    if (grid < 0) return;
    if (hipMemsetAsync((char*)d_ws + WS_CTL, 0, CTL_ZERO_BYTES, stream) != hipSuccess) { fprintf(stderr, "kernel_launch: memset failed\n"); return; }
    Args a{};
    for (int i = 0; i < 20; ++i) a.in[i] = (const float*)d_in[i];
    a.out = (float*)d_out; a.ws = (unsigned char*)d_ws;
#if MK_SINGLE_LAUNCH
    a.ph_lo = 0; a.ph_hi = N_PHASES;
    hipLaunchKernelGGL(mk_fwd, dim3(grid), dim3(NWAVES * 64), LDS_BYTES, stream, a);
#else
    for (int p = 0; p < N_PHASES; ++p) { a.ph_lo = p; a.ph_hi = p + 1; hipLaunchKernelGGL(mk_fwd, dim3(grid), dim3(NWAVES * 64), LDS_BYTES, stream, a); }
#endif
    const hipError_t le = hipPeekAtLastError();
    if (le != hipSuccess) fprintf(stderr, "kernel_launch: launch failed: %s\n", hipGetErrorName(le));
}
```
